# Optimizing an MI355X kernel written in HIP

```python
import math
import jax, jax.numpy as jnp
from jax import lax
import numpy as np

D_MODEL = 2048
BATCH = 2
SEQ = 4096
DEPTH = 2

CHUNK = 64
Q_BLOCK = 128
NORM_EPS = 1e-6

A_HEADS = 8
A_HEAD_DIM = 128
A_WIDTH = A_HEADS * 2 * A_HEAD_DIM
B_GROUPS = 8
B_WIDTH = D_MODEL
B_GROUP_DIM = B_WIDTH // B_GROUPS
B_SPAN = 128
C_WIDTH = (4 * D_MODEL // 3) // 128 * 128
C_HEADS = 16
C_BLOCK = C_WIDTH // C_HEADS
C_CONV = 4
C_GATE_C = 8.0

N_EVEN = (DEPTH + 1) // 2
N_ODD = DEPTH // 2
AB_IN = 4 * A_WIDTH + 3 * B_WIDTH
AB_MIX = A_WIDTH + B_WIDTH

kernel_name = "chunk_causal_diffattn_gmlp_rglru_hybrid"


def rms_norm(x, g):
    xf = x.astype(jnp.float32)
    y = xf * lax.rsqrt(jnp.mean(xf * xf, axis=-1, keepdims=True) + NORM_EPS)
    return (y * g.astype(jnp.float32)).astype(x.dtype)


def layer_norm(x, g, b):
    xf = x.astype(jnp.float32)
    mu = jnp.mean(xf, axis=-1, keepdims=True)
    xc = xf - mu
    y = xc * lax.rsqrt(jnp.mean(xc * xc, axis=-1, keepdims=True) + NORM_EPS)
    return (y * g.astype(jnp.float32) + b.astype(jnp.float32)).astype(x.dtype)


def diff_attention(q, k, v, lam):
    bsz, seq = q.shape[0], q.shape[1]
    nb = seq // Q_BLOCK
    k1, k2 = k[..., 0, :], k[..., 1, :]
    key_chunk = jnp.arange(seq) // CHUNK
    qb = q.reshape(bsz, nb, Q_BLOCK, A_HEADS, 2, A_HEAD_DIM).transpose(1, 0, 2, 3, 4, 5)

    def block(args):
        qblk, bi = args
        q_chunk = (bi * Q_BLOCK + jnp.arange(Q_BLOCK)) // CHUNK
        mask = key_chunk[None, :] <= q_chunk[:, None]
        s1 = jnp.einsum('bqhd,bkhd->bhqk', qblk[..., 0, :], k1).astype(jnp.float32)
        s2 = jnp.einsum('bqhd,bkhd->bhqk', qblk[..., 1, :], k2).astype(jnp.float32)
        p1 = jax.nn.softmax(jnp.where(mask, s1, -jnp.inf), axis=-1)
        p2 = jax.nn.softmax(jnp.where(mask, s2, -jnp.inf), axis=-1)
        w = (p1 - lam * p2).astype(v.dtype)
        return jnp.einsum('bhqk,bkhe->bqhe', w, v)

    out = lax.map(block, (qb, jnp.arange(nb)))
    return out.transpose(1, 0, 2, 3, 4).reshape(bsz, seq, A_HEADS, 2 * A_HEAD_DIM)


def spatial_gating(u, v, ln_g, ln_b, w_s, b_s):
    bsz, seq = v.shape[0], v.shape[1]
    n = seq // B_SPAN
    v = layer_norm(v, ln_g, ln_b)
    vg = v.reshape(bsz, n, B_SPAN, B_GROUPS, B_GROUP_DIM)
    pos_chunk = jnp.arange(B_SPAN) // CHUNK
    mask = pos_chunk[:, None] >= pos_chunk[None, :]
    w = jnp.where(mask[None], w_s, jnp.zeros_like(w_s))
    mixed = jnp.einsum('gij,bnjgc->bnigc', w, vg) + b_s.T[None, None, :, :, None]
    return u * mixed.reshape(bsz, seq, B_WIDTH)


def causal_depthwise_conv(x, w, b):
    seq = x.shape[1]
    xp = jnp.pad(x, ((0, 0), (C_CONV - 1, 0), (0, 0)))
    y = xp[:, 0:seq] * w[0]
    for t in range(1, C_CONV):
        y = y + xp[:, t:t + seq] * w[t]
    return y + b


def rg_lru(x, w_a, b_a, w_x, b_x, lam):
    bsz, seq = x.shape[0], x.shape[1]
    xh = x.reshape(bsz, seq, C_HEADS, C_BLOCK)
    r = jax.nn.sigmoid((jnp.einsum('bshi,hij->bshj', xh, w_a).reshape(bsz, seq, C_WIDTH) + b_a).astype(jnp.float32))
    i = jax.nn.sigmoid((jnp.einsum('bshi,hij->bshj', xh, w_x).reshape(bsz, seq, C_WIDTH) + b_x).astype(jnp.float32))
    log_a = -C_GATE_C * r * jax.nn.softplus(-lam.astype(jnp.float32))
    a = jnp.exp(log_a)
    beta = jnp.sqrt(-jnp.expm1(2.0 * log_a))
    bt = beta * (i * x.astype(jnp.float32))

    def combine(lhs, rhs):
        a_l, b_l = lhs
        a_r, b_r = rhs
        return a_l * a_r, a_r * b_l + b_r

    _, h = lax.associative_scan(combine, (a, bt), axis=1)
    return h.astype(x.dtype)


def setup_inputs(seed: int = 0) -> dict:
    key = jax.random.key(seed)
    ks = jax.random.split(key, 24)
    f32 = jnp.float32
    nrm = lambda k, shape, s: (jax.random.normal(k, shape, f32) * s)
    x = jax.random.normal(ks[0], (BATCH, SEQ, D_MODEL), f32)
    ab_norm = 1.0 + nrm(ks[1], (N_EVEN, D_MODEL), 0.01)
    ab_w_in = nrm(ks[2], (N_EVEN, D_MODEL, AB_IN), D_MODEL ** -0.5)
    ab_lambda = nrm(ks[3], (N_EVEN, 4, A_HEAD_DIM), 0.1)
    ab_head_norm = 1.0 + nrm(ks[4], (N_EVEN, A_WIDTH), 0.01)
    ab_sgu_ln_g = 1.0 + nrm(ks[5], (N_EVEN, B_WIDTH), 0.01)
    ab_sgu_ln_b = nrm(ks[6], (N_EVEN, B_WIDTH), 0.01)
    ab_sgu_w = nrm(ks[7], (N_EVEN, B_GROUPS, B_SPAN, B_SPAN), B_SPAN ** -0.5)
    ab_sgu_b = 1.0 + nrm(ks[8], (N_EVEN, B_GROUPS, B_SPAN), 0.01)
    ab_w_out = nrm(ks[9], (N_EVEN, AB_MIX, D_MODEL), (AB_MIX * 2 * DEPTH) ** -0.5)
    c_norm = 1.0 + nrm(ks[10], (N_ODD, D_MODEL), 0.01)
    c_w_in = nrm(ks[11], (N_ODD, D_MODEL, 2 * C_WIDTH), D_MODEL ** -0.5)
    c_conv_w = nrm(ks[12], (N_ODD, C_CONV, C_WIDTH), C_CONV ** -0.5)
    c_conv_b = nrm(ks[13], (N_ODD, C_WIDTH), 0.01)
    c_gate_a_w = nrm(ks[14], (N_ODD, C_HEADS, C_BLOCK, C_BLOCK), C_BLOCK ** -0.5)
    c_gate_a_b = nrm(ks[15], (N_ODD, C_WIDTH), 0.01)
    c_gate_x_w = nrm(ks[16], (N_ODD, C_HEADS, C_BLOCK, C_BLOCK), C_BLOCK ** -0.5)
    c_gate_x_b = nrm(ks[17], (N_ODD, C_WIDTH), 0.01)
    a_pow_c = jax.random.uniform(ks[18], (N_ODD, C_WIDTH), f32, 0.9, 0.999)
    a0 = a_pow_c ** (1.0 / C_GATE_C)
    c_lambda = jnp.log(a0) - jnp.log1p(-a0)
    c_w_out = nrm(ks[19], (N_ODD, C_WIDTH, D_MODEL), (C_WIDTH * 2 * DEPTH) ** -0.5)
    final_norm = 1.0 + nrm(ks[20], (D_MODEL,), 0.01)
    return {"x": x, "ab_norm": ab_norm, "ab_w_in": ab_w_in, "ab_lambda": ab_lambda,
            "ab_head_norm": ab_head_norm, "ab_sgu_ln_g": ab_sgu_ln_g, "ab_sgu_ln_b": ab_sgu_ln_b,
            "ab_sgu_w": ab_sgu_w, "ab_sgu_b": ab_sgu_b, "ab_w_out": ab_w_out,
            "c_norm": c_norm, "c_w_in": c_w_in, "c_conv_w": c_conv_w, "c_conv_b": c_conv_b,
            "c_gate_a_w": c_gate_a_w, "c_gate_a_b": c_gate_a_b, "c_gate_x_w": c_gate_x_w,
            "c_gate_x_b": c_gate_x_b, "c_lambda": c_lambda, "c_w_out": c_w_out,
            "final_norm": final_norm}


def reference(x, ab_norm, ab_w_in, ab_lambda, ab_head_norm, ab_sgu_ln_g, ab_sgu_ln_b,
              ab_sgu_w, ab_sgu_b, ab_w_out, c_norm, c_w_in, c_conv_w, c_conv_b,
              c_gate_a_w, c_gate_a_b, c_gate_x_w, c_gate_x_b, c_lambda, c_w_out, final_norm):
    bsz, seq = x.shape[0], x.shape[1]
    for l in range(DEPTH):
        if l % 2 == 0:
            e = l // 2
            lam_init = 0.8 - 0.6 * math.exp(-0.3 * l)
            xn = rms_norm(x, ab_norm[e])
            proj = xn @ ab_w_in[e]
            q, k, v, z_a, u_b, v_b, z_b = jnp.split(
                proj, np.cumsum([A_WIDTH, A_WIDTH, A_WIDTH, A_WIDTH, B_WIDTH, B_WIDTH]), axis=-1)
            q = q.reshape(bsz, seq, A_HEADS, 2, A_HEAD_DIM) * (A_HEAD_DIM ** -0.5)
            k = k.reshape(bsz, seq, A_HEADS, 2, A_HEAD_DIM)
            v = v.reshape(bsz, seq, A_HEADS, 2 * A_HEAD_DIM)
            lp = ab_lambda[e].astype(jnp.float32)
            lam = jnp.exp(jnp.dot(lp[0], lp[1])) - jnp.exp(jnp.dot(lp[2], lp[3])) + lam_init
            attn = diff_attention(q, k, v, lam)
            attn = rms_norm(attn, ab_head_norm[e].reshape(A_HEADS, 2 * A_HEAD_DIM)) * (1.0 - lam_init)
            y_a = attn.reshape(bsz, seq, A_WIDTH) * jax.nn.silu(z_a)
            sgu = spatial_gating(jax.nn.gelu(u_b), jax.nn.gelu(v_b), ab_sgu_ln_g[e], ab_sgu_ln_b[e],
                                 ab_sgu_w[e], ab_sgu_b[e])
            y_b = sgu * jax.nn.silu(z_b)
            y = jnp.concatenate([y_a, y_b], axis=-1) @ ab_w_out[e]
        else:
            o = l // 2
            xn = rms_norm(x, c_norm[o])
            proj = xn @ c_w_in[o]
            xb, z_c = jnp.split(proj, 2, axis=-1)
            xb = causal_depthwise_conv(xb, c_conv_w[o], c_conv_b[o])
            h = rg_lru(xb, c_gate_a_w[o], c_gate_a_b[o], c_gate_x_w[o], c_gate_x_b[o], c_lambda[o])
            y = (h * jax.nn.silu(z_c)) @ c_w_out[o]
        x = x + y
    return rms_norm(x, final_norm)
```

```cpp
#include <hip/hip_runtime.h>
#include <hip/hip_cooperative_groups.h>
#include <hip/hip_bf16.h>
#include <cstdio>
#include <cstdint>
#include <cmath>
namespace cg = cooperative_groups;
#ifndef MK_N_LAUNCHES
#define MK_N_LAUNCHES 9
#endif
namespace pg8 {
#define PG8_LAS __attribute__((address_space(3)))
typedef unsigned short bf16_t;
typedef short bf16x8 __attribute__((ext_vector_type(8)));
typedef float f32x4 __attribute__((ext_vector_type(4)));
typedef unsigned u32x4 __attribute__((ext_vector_type(4)));
constexpr int BM = 256, BK = 64, HALF = 128, HTB = HALF * BK * 2  , STAGE_BYTES = 8 * HTB, NXCD = 8, WGM = 8;

__host__ __device__ __forceinline__ int lds_byte(int r, int c) { const int st = (r >> 4) * 2 + (c >> 5), rr = r & 15, cc = c & 31, ob = rr * 64 + cc * 2; return st * 1024 + (ob ^ (((ob >> 9) & 1) << 5)); }
__host__ __device__ __forceinline__ void stage_rc(int b, int& R, int& C) { const int st = b / 1024, sb = b % 1024, swz = sb ^ (((sb >> 9) & 1) << 5); R = (st >> 1) * 16 + swz / 64; C = (st & 1) * 32 + (swz % 64) / 2; }
__host__ __device__ __forceinline__ int perm32(int rho) { const int n = rho >> 4, i = rho & 15; return 8 * (i >> 2) + 4 * n + (i & 3); }

struct Unit { int pm, pn; };
struct Gemm { const bf16_t* A; const bf16_t* Bt; int M, N, K; };

struct StaticOrder {
    int nM, nN, nwg, G, c;
    __host__ __device__ void init(int M, int N, int G_, int c_) { nM = M / BM; nN = N / BM; nwg = nM * nN; G = G_; c = c_; }
    __host__ __device__ bool next(int i, Unit& u) const {
        const long L = (long)i * G + c; if (L >= nwg) return false;
        int wgid = (int)L; { const int q = nwg / NXCD, r = nwg % NXCD, xcd = wgid % NXCD, off = wgid / NXCD; wgid = (xcd < r ? xcd * (q + 1) : r * (q + 1) + (xcd - r) * q) + off; }
        const int nig = WGM * nN, gid = wgid / nig, fm = gid * WGM, gsz = (nM - fm) < WGM ? (nM - fm) : WGM;
        u.pm = fm + ((wgid % nig) % gsz); u.pn = (wgid % nig) / gsz; return true;
    }
    __device__ __forceinline__ void a_ready(const Unit&) const {}
    __device__ __forceinline__ void done(const Unit&) const {}
};

__device__ __forceinline__ unsigned cvt_pk_bf16(float lo, float hi) { unsigned r; asm volatile("v_cvt_pk_bf16_f32 %0, %1, %2" : "=v"(r) : "v"(lo), "v"(hi)); return r; }
typedef float f32x2 __attribute__((ext_vector_type(2)));
typedef unsigned u32x2 __attribute__((ext_vector_type(2)));
__device__ __forceinline__ float silu_f(float v) { return v / (1.f + __expf(-v)); }
__device__ __forceinline__ float gelu_tanh_f(float v) { const float u = 0.7978845608028654f * (v + 0.044715f * v * v * v); return v / (1.f + __expf(-2.f * u)); }
__device__ __forceinline__ float sigmoid_f(float v) { return 1.f / (1.f + __expf(-v)); }

struct EpiProj {
    static constexpr bool PERM = true, AFTER_DRAIN = false;
    bf16_t* O; float* vsum; float* vsq;
    __device__ __forceinline__ void operator()(const f32x4 (&acc)[2][2][4][2], const Unit& u, int wr, int wc, int fr, int fq) const {
        const int seg = u.pn >> 3;
        const int row0 = u.pm * BM + wr * 64 + fr, col0 = u.pn * BM + wc * 32 + 8 * fq;
#pragma unroll
        for (int ai = 0; ai < 2; ++ai)
#pragma unroll
            for (int m = 0; m < 4; ++m) { const int row = row0 + ai * HALF + m * 16; bf16_t* rowp = O + (size_t)row * 14336 + col0; float s1 = 0.f, s2 = 0.f;
#pragma unroll
                for (int bj = 0; bj < 2; ++bj) { f32x4 v0 = acc[ai][bj][m][0], v1 = acc[ai][bj][m][1];
                    if (seg == 3 || seg == 6) {
#pragma unroll
                        for (int e = 0; e < 4; ++e) { v0[e] = silu_f(v0[e]); v1[e] = silu_f(v1[e]); }
                    } else if (seg == 4 || seg == 5) {
#pragma unroll
                        for (int e = 0; e < 4; ++e) { v0[e] = gelu_tanh_f(v0[e]); v1[e] = gelu_tanh_f(v1[e]); }
                        if (seg == 5) {
#pragma unroll
                            for (int e = 0; e < 4; ++e) { s1 += v0[e] + v1[e]; s2 += v0[e] * v0[e] + v1[e] * v1[e]; } }
                    }
                    u32x4 w; w.x = cvt_pk_bf16(v0[0], v0[1]); w.y = cvt_pk_bf16(v0[2], v0[3]); w.z = cvt_pk_bf16(v1[0], v1[1]); w.w = cvt_pk_bf16(v1[2], v1[3]);
                    *(u32x4*)(rowp + bj * HALF) = w; }
                if (seg == 5) { s1 += __shfl_xor(s1, 16); s1 += __shfl_xor(s1, 32); s2 += __shfl_xor(s2, 16); s2 += __shfl_xor(s2, 32);
                    if (fq == 0) { atomicAdd(vsum + row, s1); atomicAdd(vsq + row, s2); } } }
    }
};
template <bool WB> struct EpiRes {
    static constexpr bool PERM = false, AFTER_DRAIN = false;
    const float* base; float* out; bf16_t* ob; float* ss;
    __device__ __forceinline__ void operator()(const f32x4 (&acc)[2][2][4][2], const Unit& u, int wr, int wc, int fr, int fq) const {
        const int row0 = u.pm * BM + wr * 64 + fr, col0 = u.pn * BM + wc * 32 + 4 * fq;
#pragma unroll
        for (int ai = 0; ai < 2; ++ai)
#pragma unroll
            for (int m = 0; m < 4; ++m) { const int row = row0 + ai * HALF + m * 16; const size_t off = (size_t)row * 2048 + col0; float s = 0.f;
#pragma unroll
                for (int bj = 0; bj < 2; ++bj)
#pragma unroll
                    for (int n = 0; n < 2; ++n) { const size_t o2 = off + bj * HALF + n * 16; const f32x4 b = *(const f32x4*)(base + o2); const f32x4 o = b + acc[ai][bj][m][n];
                        *(f32x4*)(out + o2) = o; s += (o[0] * o[0] + o[1] * o[1]) + (o[2] * o[2] + o[3] * o[3]);
                        if (WB) { u32x2 w; w.x = cvt_pk_bf16(o[0], o[1]); w.y = cvt_pk_bf16(o[2], o[3]); *(u32x2*)(ob + o2) = w; } }
                s += __shfl_xor(s, 16); s += __shfl_xor(s, 32);
                if (fq == 0) atomicAdd(ss + row, s); }
    }
};
struct EpiProj2 {
    static constexpr bool PERM = true, AFTER_DRAIN = false;
    bf16_t* O; const float* ss;
    __device__ __forceinline__ void operator()(const f32x4 (&acc)[2][2][4][2], const Unit& u, int wr, int wc, int fr, int fq) const {
        const int row0 = u.pm * BM + wr * 64 + fr, colt = u.pn * BM, col0 = colt + wc * 32 + 8 * fq;
#pragma unroll
        for (int ai = 0; ai < 2; ++ai)
#pragma unroll
            for (int m = 0; m < 4; ++m) { const int row = row0 + ai * HALF + m * 16; bf16_t* rowp = O + (size_t)row * 5376 + col0;
                const float rs = rsqrtf(ss[row] * (1.f / 2048.f) + 1e-6f);
#pragma unroll
                for (int bj = 0; bj < 2; ++bj) { f32x4 v0 = acc[ai][bj][m][0] * rs, v1 = acc[ai][bj][m][1] * rs;
                    if (colt + bj * HALF >= 2688) {
#pragma unroll
                        for (int e = 0; e < 4; ++e) { v0[e] = silu_f(v0[e]); v1[e] = silu_f(v1[e]); } }
                    u32x4 w; w.x = cvt_pk_bf16(v0[0], v0[1]); w.y = cvt_pk_bf16(v0[2], v0[3]); w.z = cvt_pk_bf16(v1[0], v1[1]); w.w = cvt_pk_bf16(v1[2], v1[3]);
                    *(u32x4*)(rowp + bj * HALF) = w; } }
    }
};
template <class Epi, class Sched, bool ALIGN_EPI = false, bool SP2 = false>
__device__ __forceinline__ void gemm_phase(PG8_LAS unsigned char* lds, const Gemm g, const Sched& S, const Epi& E) {
    const int tid = threadIdx.x, wid = __builtin_amdgcn_readfirstlane(tid >> 6), lane = tid & 63, wr = wid >> 2, wc = wid & 3, fr = lane & 15, fq = lane >> 4;
    const int K = g.K, nt = K / BK;
    unsigned voffA[2], voffB[2];
#pragma unroll
    for (int i = 0; i < 2; ++i) { int R, C; stage_rc(tid * 16 + i * 8192, R, C); const int Rb = Epi::PERM ? ((R & ~31) + perm32(R & 31)) : R;
        voffA[i] = (unsigned)(R * K + C) * 2u; voffB[i] = (unsigned)(Rb * K + C) * 2u; }
    const size_t kstep = (size_t)(BK * 2);
    const size_t hstep = (size_t)HALF * K * 2;
    const size_t tstep = 2 * hstep;
    const unsigned ldsw = (unsigned)wid * 1024u;
    const int aoff = lds_byte(wr * 64 + fr, fq * 8), boff = lds_byte(wc * 32 + fr, fq * 8);
#define PG8_SA(b, h) (((b) * 2 + (h)) * HTB)
#define PG8_SB(b, h) ((4 + (b) * 2 + (h)) * HTB)
#define PG8_STAGE(bufoff, gbase, voff) do { _Pragma("unroll") for (int _i = 0; _i < 2; ++_i) \
        __builtin_amdgcn_global_load_lds((const unsigned*)((const char*)(gbase) + (voff)[_i]), (PG8_LAS unsigned*)(lds + (bufoff) + ldsw + _i * 8192), 16, 0, 0); } while (0)
#define PG8_LDA(dst, b, h) do { _Pragma("unroll") for (int m = 0; m < 4; ++m) _Pragma("unroll") for (int k = 0; k < 2; ++k) dst[m][k] = *(const PG8_LAS bf16x8*)(lds + PG8_SA(b, h) + aoff + m * 2048 + k * 1024); } while (0)
#define PG8_LDB(dst, b, h) do { _Pragma("unroll") for (int n = 0; n < 2; ++n) _Pragma("unroll") for (int k = 0; k < 2; ++k) dst[n][k] = *(const PG8_LAS bf16x8*)(lds + PG8_SB(b, h) + boff + n * 2048 + k * 1024); } while (0)
#define PG8_MMA(ai, bj, At, Bt) do { __builtin_amdgcn_s_setprio(1); _Pragma("unroll") for (int m = 0; m < 4; ++m) _Pragma("unroll") for (int n = 0; n < 2; ++n) _Pragma("unroll") for (int k = 0; k < 2; ++k) \
        acc[ai][bj][m][n] = __builtin_amdgcn_mfma_f32_16x16x32_bf16(Bt[n][k], At[m][k], acc[ai][bj][m][n], 0, 0, 0); __builtin_amdgcn_s_setprio(0); } while (0)
#define PG8_WAIT_V(n) asm volatile("s_waitcnt vmcnt(" #n ")" ::: "memory")
#define PG8_WAIT_L(n) asm volatile("s_waitcnt lgkmcnt(" #n ")" ::: "memory")
#define PG8_BAR __builtin_amdgcn_s_barrier()
#define PG8_SCHED __builtin_amdgcn_sched_barrier(0)
    Unit cur, nxt; int ui = 0;
    if (!S.next(0, cur)) return;
    f32x4 acc[2][2][4][2];
#pragma unroll
    for (int a = 0; a < 2; ++a)
#pragma unroll
        for (int b = 0; b < 2; ++b)
#pragma unroll
            for (int m = 0; m < 4; ++m)
#pragma unroll
                for (int n = 0; n < 2; ++n) acc[a][b][m][n] = (f32x4){0.f, 0.f, 0.f, 0.f};
    bf16x8 At[4][2], B0[2][2], B1[2][2];
    const char* cA = (const char*)g.A + (size_t)cur.pm * tstep; const char* cB = (const char*)g.Bt + (size_t)cur.pn * tstep;
    S.a_ready(cur);
    if constexpr (SP2) {
        PG8_STAGE(PG8_SB(0, 0), cB, voffB); PG8_STAGE(PG8_SB(0, 1), cB + hstep, voffB); PG8_STAGE(PG8_SA(0, 0), cA, voffA); PG8_STAGE(PG8_SA(0, 1), cA + hstep, voffA);
        if (wr == 1) PG8_BAR;
        PG8_WAIT_V(2); PG8_BAR;
        PG8_STAGE(PG8_SB(1, 0), cB + kstep, voffB); PG8_STAGE(PG8_SA(1, 0), cA + kstep, voffA); PG8_STAGE(PG8_SB(1, 1), cB + hstep + kstep, voffB);
        PG8_WAIT_V(6); PG8_BAR;
    } else {
        PG8_STAGE(PG8_SB(0, 0), cB, voffB); PG8_STAGE(PG8_SA(0, 0), cA, voffA); PG8_STAGE(PG8_SB(0, 1), cB + hstep, voffB); PG8_STAGE(PG8_SA(0, 1), cA + hstep, voffA);
        if (wr == 1) PG8_BAR;
        PG8_WAIT_V(4); PG8_BAR;
        PG8_STAGE(PG8_SB(1, 0), cB + kstep, voffB); PG8_STAGE(PG8_SA(1, 0), cA + kstep, voffA); PG8_STAGE(PG8_SB(1, 1), cB + hstep + kstep, voffB);
        PG8_WAIT_V(6); PG8_BAR;
    }
    for (;;) {
        const bool has_next = S.next(ui + 1, nxt);
        const char* nA = has_next ? (const char*)g.A + (size_t)nxt.pm * tstep : cA; const char* nB = has_next ? (const char*)g.Bt + (size_t)nxt.pn * tstep : cB;
        for (int t = 0; t < nt; t += 2) {
            const bool last = (t == nt - 2);
            const char* a1 = cA + (size_t)(t + 1) * kstep;
            const char* a2 = last ? nA : cA + (size_t)(t + 2) * kstep; const char* b2 = last ? nB : cB + (size_t)(t + 2) * kstep;
            const char* a3 = a2 + kstep; const char* b3 = b2 + kstep;
            if (last && has_next) S.a_ready(nxt);
            if constexpr (SP2) {
            PG8_LDB(B0, 0, 0); PG8_LDB(B1, 0, 1); PG8_SCHED; PG8_LDA(At, 0, 0); PG8_STAGE(PG8_SA(1, 1), a1 + hstep, voffA);
            PG8_WAIT_V(8); PG8_WAIT_L(0); PG8_BAR; PG8_MMA(0, 0, At, B0); PG8_MMA(0, 1, At, B1); PG8_BAR; PG8_SCHED;
            PG8_LDA(At, 0, 1); PG8_STAGE(PG8_SB(0, 0), b2, voffB); PG8_STAGE(PG8_SB(0, 1), b2 + hstep, voffB); PG8_STAGE(PG8_SA(0, 0), a2, voffA);
            PG8_WAIT_V(8); PG8_WAIT_L(0); PG8_BAR; PG8_MMA(1, 0, At, B0); PG8_MMA(1, 1, At, B1); PG8_BAR; PG8_SCHED;
            PG8_LDB(B0, 1, 0); PG8_LDB(B1, 1, 1); PG8_SCHED; PG8_LDA(At, 1, 0); PG8_STAGE(PG8_SA(0, 1), a2 + hstep, voffA);
            PG8_WAIT_V(8); PG8_WAIT_L(0); PG8_BAR; PG8_MMA(0, 0, At, B0); PG8_MMA(0, 1, At, B1); PG8_BAR; PG8_SCHED;
            PG8_LDA(At, 1, 1); PG8_STAGE(PG8_SB(1, 0), b3, voffB); PG8_STAGE(PG8_SB(1, 1), b3 + hstep, voffB); PG8_STAGE(PG8_SA(1, 0), a3, voffA);
            PG8_WAIT_V(8); PG8_WAIT_L(0); PG8_BAR; PG8_MMA(1, 0, At, B0); PG8_MMA(1, 1, At, B1); PG8_BAR; PG8_SCHED;
            } else {
            PG8_LDB(B0, 0, 0); PG8_SCHED; PG8_LDA(At, 0, 0); PG8_STAGE(PG8_SA(1, 1), a1 + hstep, voffA);
            PG8_WAIT_L(8); PG8_BAR; PG8_WAIT_L(0); PG8_MMA(0, 0, At, B0); PG8_BAR; PG8_SCHED;
            PG8_LDB(B1, 0, 1); PG8_STAGE(PG8_SB(0, 0), b2, voffB);
            PG8_BAR; PG8_WAIT_L(0); PG8_MMA(0, 1, At, B1); PG8_BAR;
            PG8_LDA(At, 0, 1); PG8_STAGE(PG8_SA(0, 0), a2, voffA);
            PG8_BAR; PG8_WAIT_L(0); PG8_MMA(1, 0, At, B0); PG8_BAR; PG8_SCHED;
            PG8_STAGE(PG8_SB(0, 1), b2 + hstep, voffB);
            PG8_WAIT_V(6); PG8_BAR; PG8_MMA(1, 1, At, B1); PG8_BAR;
            PG8_LDB(B0, 1, 0); PG8_SCHED; PG8_LDA(At, 1, 0); PG8_STAGE(PG8_SA(0, 1), a2 + hstep, voffA);
            PG8_WAIT_L(8); PG8_BAR; PG8_WAIT_L(0); PG8_MMA(0, 0, At, B0); PG8_BAR; PG8_SCHED;
            PG8_LDB(B1, 1, 1); PG8_STAGE(PG8_SB(1, 0), b3, voffB);
            PG8_BAR; PG8_WAIT_L(0); PG8_MMA(0, 1, At, B1); PG8_BAR;
            PG8_LDA(At, 1, 1); PG8_STAGE(PG8_SA(1, 0), a3, voffA);
            PG8_BAR; PG8_WAIT_L(0); PG8_MMA(1, 0, At, B0); PG8_BAR; PG8_SCHED;
            PG8_STAGE(PG8_SB(1, 1), b3 + hstep, voffB);
            PG8_WAIT_V(6); PG8_BAR; PG8_MMA(1, 1, At, B1); PG8_BAR;
            }
        }
        if constexpr (ALIGN_EPI) { if (wr == 0) PG8_BAR; }
        if constexpr (!Epi::AFTER_DRAIN) { E(acc, cur, wr, wc, fr, fq); S.done(cur); }
        if (!has_next) break;
#pragma unroll
        for (int a = 0; a < 2; ++a)
#pragma unroll
            for (int b = 0; b < 2; ++b)
#pragma unroll
                for (int m = 0; m < 4; ++m)
#pragma unroll
                    for (int n = 0; n < 2; ++n) acc[a][b][m][n] = (f32x4){0.f, 0.f, 0.f, 0.f};
        cur = nxt; cA = nA; cB = nB; ++ui;
        if constexpr (ALIGN_EPI) { if (wr == 1) PG8_BAR; }
    }
    PG8_WAIT_V(0);
    if constexpr (!ALIGN_EPI) { if (wr == 0) PG8_BAR; }
    PG8_BAR;
    if constexpr (Epi::AFTER_DRAIN) { E.fused(acc, cur, wr, wc, fr, fq, lds, wid, lane); S.done(cur); }
#undef PG8_SA
#undef PG8_SB
#undef PG8_STAGE
#undef PG8_LDA
#undef PG8_LDB
#undef PG8_MMA
#undef PG8_WAIT_V
#undef PG8_WAIT_L
#undef PG8_BAR
#undef PG8_SCHED
}
}

#ifndef PG8_SP2
#define PG8_SP2 true
#endif
namespace att {
using bf16 = __hip_bfloat16;
using bf16x8 = __attribute__((ext_vector_type(8))) short;
using s16x4  = __attribute__((ext_vector_type(4))) short;
using f32x16 = __attribute__((ext_vector_type(16))) float;
using f32x4  = __attribute__((ext_vector_type(4))) float;
using u32x4  = __attribute__((ext_vector_type(4))) unsigned;
using u32x2  = __attribute__((ext_vector_type(2))) unsigned;
constexpr float SCALE = 0.088388347648318440f;
constexpr float THR = 8.f;
constexpr int LDP = 14336;
constexpr int SUB = 16384, BUFB = 4 * SUB, ATT_WS = 2 * BUFB;
#define KSWZ(row, colB) ((row) * 256 + ((colB) ^ (((row) & 7) << 4)))
#define SBAR() __builtin_amdgcn_sched_barrier(0)
__device__ __forceinline__ int crow(int r, int hi) { return (r & 3) + 8 * (r >> 2) + 4 * hi; }
__device__ __forceinline__ unsigned cvtpk(float lo, float hi) {
  unsigned r; asm volatile("v_cvt_pk_bf16_f32 %0, %1, %2" : "=v"(r) : "v"(lo), "v"(hi)); return r;
}
__device__ __forceinline__ void partialSM(f32x16& p0, f32x16& p1, float& m_reg, float& mn, float& alpha) {
  constexpr float C = SCALE * 1.4426950408889634f;
  float pmax = p0[0]; for (int r = 1; r < 16; ++r) pmax = fmaxf(pmax, p0[r]); for (int r = 0; r < 16; ++r) pmax = fmaxf(pmax, p1[r]);
  { auto rr = __builtin_amdgcn_permlane32_swap(__float_as_uint(pmax), __float_as_uint(pmax), false, false);
    pmax = fmaxf(__uint_as_float(rr[0]), __uint_as_float(rr[1])); }
  if (__builtin_expect(__all(pmax - m_reg <= THR / SCALE), 1)) { mn = m_reg; alpha = 1.f; }
  else { mn = fmaxf(m_reg, pmax); alpha = __builtin_amdgcn_exp2f((m_reg - mn) * C); m_reg = mn; }
  float mnC = -mn * C;
  for (int r = 0; r < 16; ++r) p0[r] = fmaf(p0[r], C, mnC); for (int r = 0; r < 16; ++r) p1[r] = fmaf(p1[r], C, mnC);
  for (int r = 0; r < 16; ++r) p0[r] = __builtin_amdgcn_exp2f(p0[r]);
}
__device__ __forceinline__ void finishSM(f32x16& p0, f32x16& p1, float alpha, float& l_reg, bf16x8& pa0, bf16x8& pa1, bf16x8& pa2, bf16x8& pa3) {
  for (int r = 0; r < 16; ++r) p1[r] = __builtin_amdgcn_exp2f(p1[r]);
  float ps = 0; for (int r = 0; r < 16; ++r) ps += p0[r]; for (int r = 0; r < 16; ++r) ps += p1[r];
  { auto rr = __builtin_amdgcn_permlane32_swap(__float_as_uint(ps), __float_as_uint(ps), false, false);
    ps = __uint_as_float(rr[0]) + __uint_as_float(rr[1]); }
  l_reg = l_reg * alpha + ps;
#define PK4(P, BASE, OUT) do { unsigned a0 = cvtpk(P[BASE + 0], P[BASE + 1]), a1 = cvtpk(P[BASE + 2], P[BASE + 3]);   \
    unsigned b0 = cvtpk(P[BASE + 4], P[BASE + 5]), b1 = cvtpk(P[BASE + 6], P[BASE + 7]);                              \
    auto r0 = __builtin_amdgcn_permlane32_swap(a0, b0, false, false); auto r1 = __builtin_amdgcn_permlane32_swap(a1, b1, false, false); \
    u32x4 w = {r0[0], r1[0], r0[1], r1[1]}; OUT = *reinterpret_cast<bf16x8*>(&w); } while (0)
  PK4(p0, 0, pa0); PK4(p0, 8, pa1); PK4(p1, 0, pa2); PK4(p1, 8, pa3);
#undef PK4
}
__device__ __forceinline__ void qkt(f32x16& p0, f32x16& p1, const bf16* Ks, const bf16x8* qr, int r32, int hi) {
  p0 = f32x16{}; p1 = f32x16{};
  for (int d0 = 0; d0 < 8; ++d0) { int cb = (d0 * 16 + hi * 8) * 2;
    bf16x8 b0 = *reinterpret_cast<const bf16x8*>((const char*)Ks + KSWZ(r32, cb));
    bf16x8 b1 = *reinterpret_cast<const bf16x8*>((const char*)Ks + KSWZ(32 + r32, cb));
    p0 = __builtin_amdgcn_mfma_f32_32x32x16_bf16(b0, qr[d0], p0, 0, 0, 0);
    p1 = __builtin_amdgcn_mfma_f32_32x32x16_bf16(b1, qr[d0], p1, 0, 0, 0); }
}
__device__ __forceinline__ int v_st(int k, int c) { const int kk = (k & ~0xC) | ((k & 4) << 1) | ((k & 8) >> 1); return ((kk >> 3) * 4 + (c >> 5)) * 512 + ((kk & 7) * 32 + (c & 31)) * 2; }
__device__ __forceinline__ int v_rd_base(int lane) { return ((lane & 3) << 3) | (((lane >> 2) & 3) << 6) | (((lane >> 4) & 1) << 5) | (((lane >> 5) & 1) << 8); }
constexpr int v_rd_off(int d0, int ks, int half) { return d0 * 512 + ks * 4096 + half * 2048; }
template <int OFF> __device__ __forceinline__ s16x4 tr_read(int vb) {
  s16x4 r; asm volatile("ds_read_b64_tr_b16 %0, %1 offset:%2" : "=&v"(r) : "v"(vb), "i"(OFF) : "memory"); return r;
}
template <int D0> __device__ __forceinline__ void pv_one(f32x16& od, int vb, bf16x8 pa0, bf16x8 pa1, bf16x8 pa2, bf16x8 pa3) {
  const s16x4 l0 = tr_read<v_rd_off(D0, 0, 0)>(vb), h0 = tr_read<v_rd_off(D0, 0, 1)>(vb), l1 = tr_read<v_rd_off(D0, 1, 0)>(vb), h1 = tr_read<v_rd_off(D0, 1, 1)>(vb);
  const s16x4 l2 = tr_read<v_rd_off(D0, 2, 0)>(vb), h2 = tr_read<v_rd_off(D0, 2, 1)>(vb), l3 = tr_read<v_rd_off(D0, 3, 0)>(vb), h3 = tr_read<v_rd_off(D0, 3, 1)>(vb);
  asm volatile("s_waitcnt lgkmcnt(0)" ::: "memory"); SBAR();
#define PK(L, H) (bf16x8){L[0], L[1], L[2], L[3], H[0], H[1], H[2], H[3]}
  od = __builtin_amdgcn_mfma_f32_32x32x16_bf16(pa0, PK(l0, h0), od, 0, 0, 0);
  od = __builtin_amdgcn_mfma_f32_32x32x16_bf16(pa1, PK(l1, h1), od, 0, 0, 0);
  od = __builtin_amdgcn_mfma_f32_32x32x16_bf16(pa2, PK(l2, h2), od, 0, 0, 0);
  od = __builtin_amdgcn_mfma_f32_32x32x16_bf16(pa3, PK(l3, h3), od, 0, 0, 0);
#undef PK
}
__device__ __forceinline__ void pv_d0(f32x16* o, int vb, bf16x8 pa0, bf16x8 pa1, bf16x8 pa2, bf16x8 pa3) {
  pv_one<0>(o[0], vb, pa0, pa1, pa2, pa3); pv_one<1>(o[1], vb, pa0, pa1, pa2, pa3); pv_one<2>(o[2], vb, pa0, pa1, pa2, pa3); pv_one<3>(o[3], vb, pa0, pa1, pa2, pa3);
}
__device__ __forceinline__ float bf2f(unsigned short s) { return __uint_as_float((unsigned)s << 16); }
__device__ __forceinline__ float wave_sum(float v) {
#pragma unroll
  for (int o = 1; o < 64; o <<= 1) v += __shfl_xor(v, o);
  return v;
}
__device__ __forceinline__ void attn_unit(int b, int h, int qc, const bf16* __restrict__ proj, bf16* __restrict__ ymix, float lam, const float* __restrict__ hnorm, char* lds) {
  const int tid = threadIdx.x, wid = tid >> 6, lane = tid & 63, r32 = lane & 31, hi = lane >> 5;
  const int rg = wid & 1, map = (wid >> 1) & 1, vh = wid >> 2;
  float* ws = (float*)(lds + ATT_WS) + wid * 64; float* li_l = ws; float* al_l = ws + 32;
  const long rowbase = (long)b * 4096;
  const bf16* Kg = proj + rowbase * LDP + 2048 + h * 256;
  const bf16* Vg = proj + rowbase * LDP + 4096 + h * 256;
  const bf16* Qw = proj + (rowbase + qc * 64 + rg * 32 + r32) * LDP + h * 256 + map * 128 + hi * 8;
  float m_reg = -1e30f, l_reg = 0; f32x16 o[4] = {}; bf16x8 qr[8];
#pragma unroll
  for (int d0 = 0; d0 < 8; ++d0) qr[d0] = *reinterpret_cast<const bf16x8*>(Qw + d0 * 16);
  const int sr = tid >> 4, sc = (tid & 15) * 8, vst0 = v_st(sr, sc), vst1 = v_st(32 + sr, sc), kst0 = KSWZ(sr, sc * 2), kst1 = KSWZ(32 + sr, sc * 2);
  const int vb0 = (int)(uintptr_t)lds + 2 * SUB + vh * SUB + v_rd_base(lane);
  const bf16* Kt0 = (const bf16*)(lds + map * SUB);
  bf16x8 s0, s1, s2, s3, s4, s5, s6, s7;
#define SLOAD(k0) do { const bf16* kp = Kg + (long)((k0) + sr) * LDP + sc; const bf16* vp = Vg + (long)((k0) + sr) * LDP + sc; \
    s0 = *(const bf16x8*)kp; s1 = *(const bf16x8*)(kp + 32L * LDP); s2 = *(const bf16x8*)(kp + 128); s3 = *(const bf16x8*)(kp + 32L * LDP + 128); \
    s4 = *(const bf16x8*)vp; s5 = *(const bf16x8*)(vp + 32L * LDP); s6 = *(const bf16x8*)(vp + 128); s7 = *(const bf16x8*)(vp + 32L * LDP + 128); } while (0)
#define SWRITE(bf) do { char* bb = lds + (bf) * BUFB; *(bf16x8*)(bb + kst0) = s0; *(bf16x8*)(bb + kst1) = s1; *(bf16x8*)(bb + SUB + kst0) = s2; *(bf16x8*)(bb + SUB + kst1) = s3; \
    *(bf16x8*)(bb + 2 * SUB + vst0) = s4; *(bf16x8*)(bb + 2 * SUB + vst1) = s5; *(bf16x8*)(bb + 3 * SUB + vst0) = s6; *(bf16x8*)(bb + 3 * SUB + vst1) = s7; } while (0)
#define SWAIT() asm volatile("s_waitcnt vmcnt(0)" ::: "memory")
#define RESC(a) do { if (__any((a) < 1.f)) { if (hi == 0) al_l[r32] = (a); asm volatile("s_waitcnt lgkmcnt(0)" ::: "memory"); \
    for (int d = 0; d < 4; ++d) for (int r = 0; r < 16; ++r) o[d][r] *= al_l[crow(r, hi)]; } } while (0)
  f32x16 p0, p1; float mn, al; bf16x8 pa0, pa1, pa2, pa3; const int NT = qc + 1;
  SLOAD(0); SWAIT(); SWRITE(0); __syncthreads();
  for (int j = 0; j < NT; ++j) {
    const int bo = (j & 1) * BUFB; const bool more = (j + 1 < NT);
    if (more) SLOAD((j + 1) * 64);
    SBAR(); qkt(p0, p1, (const bf16*)((const char*)Kt0 + bo), qr, r32, hi);
    partialSM(p0, p1, m_reg, mn, al); RESC(al);
    finishSM(p0, p1, al, l_reg, pa0, pa1, pa2, pa3); SBAR();
    pv_d0(o, vb0 + bo, pa0, pa1, pa2, pa3);
    if (more) { SWAIT(); SWRITE((j + 1) & 1); }
    __syncthreads();
  }
  if (hi == 0) li_l[r32] = l_reg;
  __syncthreads();
  { float* Ob = (float*)lds + wid * 4096;
#pragma unroll
    for (int r = 0; r < 16; ++r) { const int orow = crow(r, hi);
#pragma unroll
      for (int d0 = 0; d0 < 4; ++d0) Ob[orow * 128 + d0 * 32 + r32] = o[d0][r]; } }
  __syncthreads();
  const float* lall = (const float*)(lds + ATT_WS);
#pragma unroll 1
  for (int rr = 0; rr < 8; ++rr) {
    const int row = wid * 8 + rr, rg2 = row >> 5, r5 = row & 31, c = lane * 4, vh2 = c >> 7, cc = c & 127, w1 = rg2 + 4 * vh2;
    const float* O1 = (const float*)lds + w1 * 4096 + r5 * 128 + cc;
    const float il1 = 1.f / lall[w1 * 64 + r5], il2 = lam / lall[(w1 + 2) * 64 + r5];
    const f32x4 a = *(const f32x4*)O1 * il1, b2 = *(const f32x4*)(O1 + 2 * 4096) * il2;
    const f32x4 d = a - b2;
    const float ssq = wave_sum((d[0] * d[0] + d[1] * d[1]) + (d[2] * d[2] + d[3] * d[3]));
    const float rstd = rsqrtf(ssq * (1.f / 256.f) + 1e-6f) * 0.8f;
    const f32x4 g = *(const f32x4*)(hnorm + h * 256 + c);
    const long grow = rowbase + qc * 64 + row;
    const u32x2 zz = *(const u32x2*)(proj + grow * LDP + 6144 + h * 256 + c);
    const float z0 = __uint_as_float(zz.x << 16), z1 = __uint_as_float(zz.x & 0xffff0000u), z2 = __uint_as_float(zz.y << 16), z3 = __uint_as_float(zz.y & 0xffff0000u);
    u32x2 w; w.x = cvtpk(d[0] * rstd * g[0] * z0, d[1] * rstd * g[1] * z1); w.y = cvtpk(d[2] * rstd * g[2] * z2, d[3] * rstd * g[3] * z3);
    *(u32x2*)(ymix + grow * 4096 + h * 256 + c) = w;
  }
  __syncthreads();
#undef SLOAD
#undef SWRITE
#undef SWAIT
#undef RESC
}
__device__ __forceinline__ void sgu_unit(int n, int g, const bf16* __restrict__ proj, bf16* __restrict__ ymix, const bf16* __restrict__ Wsb, const float* __restrict__ vsum, const float* __restrict__ vsq,
                                         const float* __restrict__ ln_g, const float* __restrict__ ln_b, const float* __restrict__ b_s, char* lds) {
  const int tid = threadIdx.x, wid = tid >> 6, lane = tid & 63, r32 = lane & 31, hi = lane >> 5;
  unsigned short* vT = (unsigned short*)lds;
  float* mean_l = (float*)(lds + 256 * 136 * 2); float* rstd_l = mean_l + 128;
  const long t0 = (long)n * 128; const int c0 = g * 256;
  if (tid < 128) { const float m = vsum[t0 + tid] * (1.f / 2048.f); const float var = vsq[t0 + tid] * (1.f / 2048.f) - m * m; mean_l[tid] = m; rstd_l[tid] = rsqrtf(fmaxf(var, 0.f) + 1e-6f); }
  __syncthreads();
#pragma unroll 2
  for (int k = 0; k < 8; ++k) { const int item = tid + 512 * k, t = item >> 5, c = (item & 31) * 8;
    const u32x4 raw = *(const u32x4*)(proj + (t0 + t) * LDP + 10240 + c0 + c);
    const f32x4 g0 = *(const f32x4*)(ln_g + c0 + c), g1 = *(const f32x4*)(ln_g + c0 + c + 4), b0 = *(const f32x4*)(ln_b + c0 + c), b1 = *(const f32x4*)(ln_b + c0 + c + 4);
    const float mu = mean_l[t], rs = rstd_l[t];
    float v[8] = {__uint_as_float(raw.x << 16), __uint_as_float(raw.x & 0xffff0000u), __uint_as_float(raw.y << 16), __uint_as_float(raw.y & 0xffff0000u),
                  __uint_as_float(raw.z << 16), __uint_as_float(raw.z & 0xffff0000u), __uint_as_float(raw.w << 16), __uint_as_float(raw.w & 0xffff0000u)};
#pragma unroll
    for (int e = 0; e < 8; ++e) { const float gg = e < 4 ? g0[e & 3] : g1[e & 3], bb = e < 4 ? b0[e & 3] : b1[e & 3];
      const float val = (v[e] - mu) * rs * gg + bb; vT[(c + e) * 136 + t] = (unsigned short)(cvtpk(val, 0.f) & 0xffffu); } }
  __syncthreads();
  f32x16 acc[4] = {};
#pragma unroll 2
  for (int ks = 0; ks < 8; ++ks) { const bf16x8 B = *(const bf16x8*)(vT + (32 * wid + r32) * 136 + ks * 16 + hi * 8);
#pragma unroll
    for (int m = 0; m < 4; ++m) { const bf16x8 A = *(const bf16x8*)(Wsb + g * 16384 + (32 * m + r32) * 128 + ks * 16 + hi * 8);
      acc[m] = __builtin_amdgcn_mfma_f32_32x32x16_bf16(A, B, acc[m], 0, 0, 0); } }
  const int c = c0 + 32 * wid + r32;
#pragma unroll
  for (int m = 0; m < 4; ++m)
#pragma unroll
    for (int r = 0; r < 16; ++r) { const int i = 32 * m + crow(r, hi); const long row = t0 + i;
      const float mixed = acc[m][r] + b_s[g * 128 + i];
      const float u = bf2f(*(const unsigned short*)(proj + row * LDP + 8192 + c)), sz = bf2f(*(const unsigned short*)(proj + row * LDP + 12288 + c));
      *(unsigned short*)(ymix + row * 4096 + 2048 + c) = (unsigned short)(cvtpk(u * mixed * sz, 0.f) & 0xffffu);
      if ((r & 3) == 3) asm volatile("" ::: "memory"); }
  __syncthreads();
}
}
#define LAS __attribute__((address_space(3)))
typedef unsigned short bf16;
typedef unsigned v4u __attribute__((ext_vector_type(4)));
typedef unsigned v2u __attribute__((ext_vector_type(2)));
typedef float f32x4 __attribute__((ext_vector_type(4)));
typedef float f32x16 __attribute__((ext_vector_type(16)));
typedef short bf16x8 __attribute__((ext_vector_type(8)));
constexpr int NWAVES = 8;
constexpr int M = 8192, DM = 2048, SEQ = 4096, NIN = 14336, NMIX = 4096, CW = 2688, NCIN = 5376;
constexpr size_t MiB = 1u << 20;
constexpr size_t WS_STATS = 0;
constexpr size_t WS_SUMA = 1 * MiB, WS_SUMH = 3 * MiB;
constexpr size_t WS_WGT = 5 * MiB;
constexpr size_t WS_WSB = 8 * MiB;
constexpr size_t WS_WTOUT = 9 * MiB;
constexpr size_t WS_WTCIN = 25 * MiB;
constexpr size_t WS_WTCOUT = 46 * MiB;
constexpr size_t WS_WTIN = 57 * MiB;
constexpr size_t WS_XN = 113 * MiB;
constexpr size_t WS_YMIX = 57 * MiB, WS_YMIX2 = 57 * MiB;
constexpr size_t WS_PROJ = 145 * MiB;
constexpr size_t WS_X1B = 145 * MiB;
constexpr size_t WS_PROJ2 = 177 * MiB;
constexpr size_t WS_HL = 261 * MiB, WS_PP = 303 * MiB;
constexpr size_t WS_END = 369 * MiB;
constexpr int LDS_BYTES = 147456;

__device__ __forceinline__ unsigned f2bf(float f) { unsigned u = __builtin_bit_cast(unsigned, f); return (u + 0x7fffu + ((u >> 16) & 1u)) >> 16; }
__device__ __forceinline__ unsigned pk2(float lo, float hi) { return f2bf(lo) | (f2bf(hi) << 16); }
__device__ __forceinline__ float bf2f(unsigned short s) { return __uint_as_float((unsigned)s << 16); }
__device__ __forceinline__ float wave_sum(float v) {
#pragma unroll
    for (int o = 1; o < 64; o <<= 1) v += __shfl_xor(v, o);
    return v;
}
__device__ __forceinline__ int crow(int r, int hi) { return (r & 3) + 8 * (r >> 2) + 4 * hi; }

__device__ __forceinline__ void p0_transpose_item(const float* __restrict__ W, int K, int N, bf16* __restrict__ WT, const float* __restrict__ kscale, float* scr, int item, int lane) {
    const int nblk = N / 32, kb = item / nblk, nb = item % nblk, k0 = 64 * kb, n0 = 32 * nb;
#pragma unroll 8
    for (int i = 0; i < 32; ++i) { const int kk = 2 * i + (lane >> 5); float v = W[(size_t)(k0 + kk) * N + n0 + (lane & 31)]; if (kscale) v *= kscale[k0 + kk]; scr[kk * 33 + (lane & 31)] = v; }
    asm volatile("s_waitcnt lgkmcnt(0)" ::: "memory");
    const int c = lane & 7;
#pragma unroll
    for (int j = 0; j < 4; ++j) { const int n = (lane >> 3) + 8 * j; const float* s = scr + (8 * c) * 33 + n;
        v4u o; o.x = pk2(s[0 * 33], s[1 * 33]); o.y = pk2(s[2 * 33], s[3 * 33]); o.z = pk2(s[4 * 33], s[5 * 33]); o.w = pk2(s[6 * 33], s[7 * 33]);
        *(v4u*)(WT + (size_t)(n0 + n) * K + k0 + 8 * c) = o; }
    asm volatile("s_waitcnt lgkmcnt(0)" ::: "memory");
}

struct Args { const float* in[21]; float* out; unsigned char* ws; int ph_lo, ph_hi; };

__device__ __forceinline__ void lru_unit(int b, int hd, int tc, const bf16* __restrict__ proj2, const bf16* __restrict__ WgT, const float* __restrict__ conv_w, const float* __restrict__ conv_b,
                                         const float* __restrict__ b_a, const float* __restrict__ b_x, const float* __restrict__ lam, bf16* __restrict__ HL, bf16* __restrict__ PP,
                                         float* __restrict__ sumA, float* __restrict__ sumH, char* lds) {
    const int tid = threadIdx.x, wid = tid >> 6, lane = tid & 63, r32 = lane & 31, hi = lane >> 5;
    bf16* xcb = (bf16*)lds;
    float* abuf = (float*)(lds + 25600);
    float* bbuf = abuf + 64 * 168;
    float* segA = bbuf + 64 * 168;
    float* segH = segA + 3 * 168;
    const long row0 = (long)b * SEQ + tc * 64;
    for (int idx = tid; idx < 64 * 32; idx += 512) xcb[(idx >> 5) * 200 + 168 + (idx & 31)] = 0;
    for (int it = tid; it < 64 * 168; it += 512) { const int t = it / 168, c = it - t * 168, C = hd * 168 + c, tl = tc * 64 + t;
        float acc = conv_b[C];
#pragma unroll
        for (int k = 0; k < 4; ++k) { const int tt = tl - 3 + k; if (tt >= 0) acc += conv_w[k * CW + C] * bf2f(proj2[((long)b * SEQ + tt) * NCIN + C]); }
        xcb[t * 200 + c] = (bf16)f2bf(acc); bbuf[it] = acc; }
    __syncthreads();
    for (int item = wid; item < 12; item += 8) { const int m = item & 1, n = item >> 1;
        f32x16 accr = {}, acci = {};
        const bf16* wr_ = WgT + ((size_t)(hd * 2 + 0) * 192 + 32 * n + r32) * 192 + hi * 8; const bf16* wi_ = wr_ + 192 * 192;
#pragma unroll
        for (int ks = 0; ks < 12; ++ks) { const bf16x8 A = *(const bf16x8*)(xcb + (32 * m + r32) * 200 + ks * 16 + hi * 8);
            const bf16x8 Br = *(const bf16x8*)(wr_ + ks * 16), Bi = *(const bf16x8*)(wi_ + ks * 16);
            accr = __builtin_amdgcn_mfma_f32_32x32x16_bf16(A, Br, accr, 0, 0, 0); acci = __builtin_amdgcn_mfma_f32_32x32x16_bf16(A, Bi, acci, 0, 0, 0); }
        const int j = 32 * n + r32;
        if (j < 168) { const int C = hd * 168 + j; const float ba = b_a[C], bx = b_x[C], sp = log1pf(__expf(-lam[C]));
#pragma unroll
            for (int r = 0; r < 16; ++r) { const int t = 32 * m + crow(r, hi);
                const float rg = 1.f / (1.f + __expf(-(accr[r] + ba))), ig = 1.f / (1.f + __expf(-(acci[r] + bx)));
                const float la = -8.f * rg * sp, a = __expf(la), beta = sqrtf(-expm1f(2.f * la));
                const float xv = bbuf[t * 168 + j]; abuf[t * 168 + j] = a; bbuf[t * 168 + j] = beta * ig * xv; } }
    }
    __syncthreads();
    if (tid < 504) { const int seg = tid / 168, c = tid - seg * 168; const int t0 = seg == 0 ? 0 : (seg == 1 ? 22 : 43), t1 = seg == 0 ? 22 : (seg == 1 ? 43 : 64);
        float P = 1.f, h = 0.f;
        for (int t = t0; t < t1; ++t) { const float a = abuf[t * 168 + c], bb = bbuf[t * 168 + c]; h = a * h + bb; P *= a; abuf[t * 168 + c] = P; bbuf[t * 168 + c] = h; }
        segA[seg * 168 + c] = P; segH[seg * 168 + c] = h; }
    __syncthreads();
    for (int it = tid; it < 64 * 168; it += 512) { const int t = it / 168, c = it - t * 168, C = hd * 168 + c;
        float Pin = 1.f, Hin = 0.f;
        if (t >= 43) { Pin = segA[c] * segA[168 + c]; Hin = segA[168 + c] * segH[c] + segH[168 + c]; } else if (t >= 22) { Pin = segA[c]; Hin = segH[c]; }
        const float hl = bbuf[it] + abuf[it] * Hin, P = abuf[it] * Pin;
        HL[(row0 + t) * CW + C] = (bf16)f2bf(hl); PP[(row0 + t) * CW + C] = (bf16)f2bf(P);
        if (t == 63) { sumA[(size_t)(b * 64 + tc) * CW + C] = P; sumH[(size_t)(b * 64 + tc) * CW + C] = hl; } }
    __syncthreads();
}
__device__ __forceinline__ void carry_unit(int u, const bf16* __restrict__ HL, const bf16* __restrict__ PP, const bf16* __restrict__ proj2, const float* __restrict__ sumA, const float* __restrict__ sumH,
                                           bf16* __restrict__ ymix2, char* lds) {
    const int tid = threadIdx.x; const int chunk = u >> 1, half = u & 1, b = chunk >> 6, cbase = half * 1344;
    float* carry = (float*)lds;
    for (int c = tid; c < 1344; c += 512) { const int C = cbase + c; float h = 0.f;
#pragma unroll 8
        for (int cc = b * 64; cc < chunk; ++cc) h = sumA[(size_t)cc * CW + C] * h + sumH[(size_t)cc * CW + C];
        carry[c] = h; }
    __syncthreads();
    for (int it = tid; it < 64 * 168; it += 512) { const int t = it / 168, v = it - t * 168; const long row = (long)chunk * 64 + t; const int C = cbase + v * 8;
        const v4u hl = *(const v4u*)(HL + row * CW + C), pp = *(const v4u*)(PP + row * CW + C), sz = *(const v4u*)(proj2 + row * NCIN + CW + C);
        const f32x4 c0 = *(const f32x4*)(carry + v * 8), c1 = *(const f32x4*)(carry + v * 8 + 4);
        v4u o;
#define LO(x) __uint_as_float((x) << 16)
#define HI(x) __uint_as_float((x) & 0xffff0000u)
        o.x = pk2((LO(hl.x) + LO(pp.x) * c0[0]) * LO(sz.x), (HI(hl.x) + HI(pp.x) * c0[1]) * HI(sz.x));
        o.y = pk2((LO(hl.y) + LO(pp.y) * c0[2]) * LO(sz.y), (HI(hl.y) + HI(pp.y) * c0[3]) * HI(sz.y));
        o.z = pk2((LO(hl.z) + LO(pp.z) * c1[0]) * LO(sz.z), (HI(hl.z) + HI(pp.z) * c1[1]) * HI(sz.z));
        o.w = pk2((LO(hl.w) + LO(pp.w) * c1[2]) * LO(sz.w), (HI(hl.w) + HI(pp.w) * c1[3]) * HI(sz.w));
#undef LO
#undef HI
        *(v4u*)(ymix2 + row * CW + C) = o; }
    __syncthreads();
}

__global__ void __launch_bounds__(NWAVES * 64, 2) mk_fwd(Args args) {
    extern __shared__ __attribute__((aligned(16))) unsigned char lds[];
    const int tid = threadIdx.x, lane = tid & 63, wave = __builtin_amdgcn_readfirstlane(tid >> 6);
    const int G = gridDim.x; const int bx = blockIdx.x; const int vcu = (G % 8 == 0) ? (bx % 8) * (G / 8) + bx / 8 : bx;
    typedef const float* cfp; typedef __attribute__((address_space(4))) const volatile unsigned long long* kaq;
    const kaq kap = (kaq)__builtin_amdgcn_kernarg_segment_ptr();
#define KIN(i) ((cfp)(kap[(i)]))
    unsigned char* ws = (unsigned char*)(kap[22]);
#define K_x KIN(0)
#define K_ab_norm KIN(1)
#define K_ab_w_in KIN(2)
#define K_ab_lambda KIN(3)
#define K_ab_head_norm KIN(4)
#define K_sgu_ln_g KIN(5)
#define K_sgu_ln_b KIN(6)
#define K_sgu_w KIN(7)
#define K_sgu_b KIN(8)
#define K_ab_w_out KIN(9)
#define K_c_norm KIN(10)
#define K_c_w_in KIN(11)
#define K_c_conv_w KIN(12)
#define K_c_conv_b KIN(13)
#define K_c_gate_a_w KIN(14)
#define K_c_gate_a_b KIN(15)
#define K_c_gate_x_w KIN(16)
#define K_c_gate_x_b KIN(17)
#define K_c_lambda KIN(18)
#define K_c_w_out KIN(19)
#define K_final_norm KIN(20)
#define K_out ((float*)(kap[21]))
    float* ss1 = (float*)(ws + WS_STATS); float* ss2 = ss1 + M; float* vsum = ss2 + M; float* vsq = vsum + M;
    float* sumA = (float*)(ws + WS_SUMA); float* sumH = (float*)(ws + WS_SUMH);
    bf16* WgT = (bf16*)(ws + WS_WGT); bf16* Wsb = (bf16*)(ws + WS_WSB);
    bf16* WtOut = (bf16*)(ws + WS_WTOUT); bf16* WtCin = (bf16*)(ws + WS_WTCIN); bf16* WtCout = (bf16*)(ws + WS_WTCOUT); bf16* WtIn = (bf16*)(ws + WS_WTIN);
    bf16* XN = (bf16*)(ws + WS_XN); bf16* YMIX = (bf16*)(ws + WS_YMIX); bf16* YMIX2 = (bf16*)(ws + WS_YMIX2); bf16* PROJ = (bf16*)(ws + WS_PROJ);
    bf16* X1B = (bf16*)(ws + WS_X1B); bf16* PROJ2 = (bf16*)(ws + WS_PROJ2); bf16* HL = (bf16*)(ws + WS_HL); bf16* PP = (bf16*)(ws + WS_PP);
    const int lo = args.ph_lo, hi = args.ph_hi;
#ifndef PH_MASK
#define PH_MASK 0x1ff
#endif
#define IN(k) (((PH_MASK >> (k)) & 1) && lo <= (k) && (k) < hi)
#if MK_N_LAUNCHES == 1
#define SEAM(k) do { if (IN(k) && IN((k) + 1)) { cg::this_grid().sync(); } } while (0)
#else
#define SEAM(k) do { } while (0)
#endif
    const int gw = vcu * NWAVES + wave, NGW = G * NWAVES; const int gt = bx * 512 + tid, NGT = G * 512;

    if (IN(0)) {
        for (int i = gt; i < 4 * M; i += NGT) ss1[i] = 0.f;
        float* scr = (float*)(lds + wave * 16384);
        constexpr int I_IN = (DM / 64) * (NIN / 32), I_OUT = (NMIX / 64) * (DM / 32), I_CIN = (DM / 64) * (NCIN / 32), I_COUT = (CW / 64) * (DM / 32);
        for (int it = gw; it < I_IN + I_OUT + I_CIN + I_COUT; it += NGW) {
            int r = it;
            if (r < I_IN) { p0_transpose_item(K_ab_w_in, DM, NIN, WtIn, nullptr, scr, r, lane); continue; } r -= I_IN;
            if (r < I_OUT) { p0_transpose_item(K_ab_w_out, NMIX, DM, WtOut, nullptr, scr, r, lane); continue; } r -= I_OUT;
            if (r < I_CIN) { p0_transpose_item(K_c_w_in, DM, NCIN, WtCin, K_c_norm, scr, r, lane); continue; } r -= I_CIN;
            p0_transpose_item(K_c_w_out, CW, DM, WtCout, nullptr, scr, r, lane);
        }
        for (int i = gt; i < 16 * 2 * 192 * 192; i += NGT) { const int ii = i % 192, j = (i / 192) % 192, gate = (i / (192 * 192)) & 1, hd = i / (2 * 192 * 192);
            float v = 0.f; if (ii < 168 && j < 168) v = (gate ? K_c_gate_x_w : K_c_gate_a_w)[((size_t)hd * 168 + ii) * 168 + j];
            WgT[i] = (bf16)f2bf(v); }
        for (int i = gt; i < 8 * 128 * 128; i += NGT) { const int j = i & 127, ii = (i >> 7) & 127; Wsb[i] = ((ii >> 6) >= (j >> 6)) ? (bf16)f2bf(K_sgu_w[i]) : (bf16)0; }
        const float* x_ = K_x; const float* abn_ = K_ab_norm;
        for (int m = gw; m < M; m += NGW) {
            const f32x4* xr = (const f32x4*)(x_ + (size_t)m * DM) + lane; f32x4 v[8]; float s = 0.f;
#pragma unroll
            for (int j = 0; j < 8; ++j) { v[j] = xr[64 * j]; s += (v[j][0] * v[j][0] + v[j][1] * v[j][1]) + (v[j][2] * v[j][2] + v[j][3] * v[j][3]); }
            const float rs = rsqrtf(wave_sum(s) * (1.f / DM) + 1e-6f);
            unsigned long long* o8 = (unsigned long long*)(XN + (size_t)m * DM) + lane;
#pragma unroll
            for (int j = 0; j < 8; ++j) { const f32x4 g = ((const f32x4*)abn_)[lane + 64 * j];
                o8[64 * j] = (unsigned long long)pk2(v[j][0] * rs * g[0], v[j][1] * rs * g[1]) | ((unsigned long long)pk2(v[j][2] * rs * g[2], v[j][3] * rs * g[3]) << 32); }
        }
        __syncthreads();
    }
    SEAM(0);
    if (IN(1)) {
        pg8::Gemm g{XN, WtIn, M, NIN, DM}; pg8::StaticOrder S; S.init(M, NIN, G, bx);
        pg8::EpiProj E{PROJ, vsum, vsq};
        pg8::gemm_phase<pg8::EpiProj, pg8::StaticOrder, true, true>((LAS unsigned char*)lds, g, S, E);
    }
    SEAM(1);
    if (IN(2)) {
        float lam;
        { const float a0 = K_ab_lambda[lane] * K_ab_lambda[128 + lane] + K_ab_lambda[64 + lane] * K_ab_lambda[192 + lane];
          const float a1 = K_ab_lambda[256 + lane] * K_ab_lambda[384 + lane] + K_ab_lambda[320 + lane] * K_ab_lambda[448 + lane];
          lam = __expf(wave_sum(a0)) - __expf(wave_sum(a1)) + 0.2f; }
#ifndef NO_ATT
        for (int p = vcu; p < 512; p += G) { const int bh = p >> 5, s = p & 31;
#pragma unroll 1
            for (int k = 0; k < 2; ++k) att::attn_unit(bh >> 3, bh & 7, k ? s : 63 - s, (const att::bf16*)PROJ, (att::bf16*)YMIX, lam, K_ab_head_norm, (char*)lds); }
#endif
#ifndef NO_SGU
        for (int u = vcu; u < 512; u += G) att::sgu_unit(u >> 3, u & 7, (const att::bf16*)PROJ, (att::bf16*)YMIX, (const att::bf16*)Wsb, vsum, vsq, K_sgu_ln_g, K_sgu_ln_b, K_sgu_b, (char*)lds);
#endif
    }
    SEAM(2);
    if (IN(3)) {
        pg8::Gemm g{YMIX, WtOut, M, DM, NMIX}; pg8::StaticOrder S; S.init(M, DM, G, bx);
        pg8::EpiRes<true> E{K_x, K_out, X1B, ss1};
        pg8::gemm_phase<pg8::EpiRes<true>, pg8::StaticOrder, true, true>((LAS unsigned char*)lds, g, S, E);
    }
    SEAM(3);
    if (IN(4)) {
        pg8::Gemm g{X1B, WtCin, M, NCIN, DM}; pg8::StaticOrder S; S.init(M, NCIN, G, bx);
        pg8::EpiProj2 E{PROJ2, ss1};
        pg8::gemm_phase<pg8::EpiProj2, pg8::StaticOrder, true, true>((LAS unsigned char*)lds, g, S, E);
    }
    SEAM(4);
    if (IN(5)) {
        for (int u = vcu; u < 2048; u += G) { const int bh = u >> 6, tc = u & 63;
            lru_unit(bh >> 4, bh & 15, tc, PROJ2, WgT, K_c_conv_w, K_c_conv_b, K_c_gate_a_b, K_c_gate_x_b, K_c_lambda, HL, PP, sumA, sumH, (char*)lds); }
    }
    SEAM(5);
    if (IN(6)) {
        for (int u = vcu; u < 256; u += G) carry_unit(u, HL, PP, PROJ2, sumA, sumH, YMIX2, (char*)lds);
    }
    SEAM(6);
    if (IN(7)) {
        pg8::Gemm g{YMIX2, WtCout, M, DM, CW}; pg8::StaticOrder S; S.init(M, DM, G, bx);
        pg8::EpiRes<false> E{K_out, K_out, nullptr, ss2};
        pg8::gemm_phase<pg8::EpiRes<false>, pg8::StaticOrder, true, true>((LAS unsigned char*)lds, g, S, E);
    }
    SEAM(7);
    if (IN(8)) {
        for (int m = gw; m < M; m += NGW) { f32x4* xr = (f32x4*)(K_out + (size_t)m * DM) + lane; const float rs = rsqrtf(ss2[m] * (1.f / DM) + 1e-6f);
#pragma unroll
            for (int j = 0; j < 8; ++j) { const f32x4 g = ((const f32x4*)K_final_norm)[lane + 64 * j]; f32x4 v = xr[64 * j]; v = v * rs * g; xr[64 * j] = v; } }
    }
#undef IN
#undef SEAM
}

extern "C" void kernel_launch(void* const* d_in, const int* in_sizes, int n_in, void* d_out, int out_size, void* d_ws, size_t ws_size, hipStream_t stream) {
    static int grid = 0;
    if (grid == 0) {
        if (n_in != 21 || out_size != M * DM || ws_size < WS_END) { fprintf(stderr, "kernel_launch: unexpected shapes (n_in %d out %d ws %zu)\n", n_in, out_size, ws_size); grid = -1; return; }
        int dev = 0, cus = 0, per_cu = 0;
        (void)hipGetDevice(&dev); (void)hipDeviceGetAttribute(&cus, hipDeviceAttributeMultiprocessorCount, dev);
        if (hipFuncSetAttribute((const void*)mk_fwd, hipFuncAttributeMaxDynamicSharedMemorySize, LDS_BYTES) != hipSuccess) { fprintf(stderr, "kernel_launch: hipFuncSetAttribute failed\n"); grid = -1; return; }
        (void)hipOccupancyMaxActiveBlocksPerMultiprocessor(&per_cu, (const void*)mk_fwd, NWAVES * 64, LDS_BYTES);
        (void)hipGetLastError();
        if (per_cu < 1) { fprintf(stderr, "kernel_launch: occupancy query says %d blocks per CU\n", per_cu); per_cu = 1; }
        grid = cus;
    }
    if (grid < 0) return;
    Args a{};
    for (int i = 0; i < 21; ++i) a.in[i] = (const float*)d_in[i];
    a.out = (float*)d_out; a.ws = (unsigned char*)d_ws;
#if MK_N_LAUNCHES == 1
    a.ph_lo = 0; a.ph_hi = 9;
    void* kargs[] = {&a};
    hipError_t e = hipLaunchCooperativeKernel((const void*)mk_fwd, dim3(grid), dim3(NWAVES * 64), kargs, LDS_BYTES, stream);
    if (e != hipSuccess) fprintf(stderr, "kernel_launch: cooperative launch failed: %s (grid %d)\n", hipGetErrorString(e), grid);
#else
    for (int p = 0; p < 9; ++p) { a.ph_lo = p; a.ph_hi = p + 1; hipLaunchKernelGGL(mk_fwd, dim3(grid), dim3(NWAVES * 64), LDS_BYTES, stream, a); }
#endif
}
```

```cpp
#include <hip/hip_runtime.h>
#include <hip/hip_cooperative_groups.h>
#include <hip/hip_bf16.h>
#include <cstdio>
#include <cstdint>
#include <cmath>
namespace cg = cooperative_groups;
#ifndef MK_N_LAUNCHES
#define MK_N_LAUNCHES 1
#endif
namespace pg8 {
#define PG8_LAS __attribute__((address_space(3)))
typedef unsigned short bf16_t;
typedef short bf16x8 __attribute__((ext_vector_type(8)));
typedef float f32x4 __attribute__((ext_vector_type(4)));
typedef unsigned u32x4 __attribute__((ext_vector_type(4)));
constexpr int BM = 256, BK = 64, HALF = 128, HTB = HALF * BK * 2  , STAGE_BYTES = 8 * HTB, NXCD = 8, WGM = 8;

__host__ __device__ __forceinline__ int lds_byte(int r, int c) { const int st = (r >> 4) * 2 + (c >> 5), rr = r & 15, cc = c & 31, ob = rr * 64 + cc * 2; return st * 1024 + (ob ^ (((ob >> 9) & 1) << 5)); }
__host__ __device__ __forceinline__ void stage_rc(int b, int& R, int& C) { const int st = b / 1024, sb = b % 1024, swz = sb ^ (((sb >> 9) & 1) << 5); R = (st >> 1) * 16 + swz / 64; C = (st & 1) * 32 + (swz % 64) / 2; }
__host__ __device__ __forceinline__ int perm32(int rho) { const int n = rho >> 4, i = rho & 15; return 8 * (i >> 2) + 4 * n + (i & 3); }

struct Unit { int pm, pn; };
struct Gemm { const bf16_t* A; const bf16_t* Bt; int M, N, K; };

struct StaticOrder {
    int nM, nN, nwg, G, c;
    __host__ __device__ void init(int M, int N, int G_, int c_) { nM = M / BM; nN = N / BM; nwg = nM * nN; G = G_; c = c_; }
    __host__ __device__ bool next(int i, Unit& u) const {
        const long L = (long)i * G + c; if (L >= nwg) return false;
        int wgid = (int)L; { const int q = nwg / NXCD, r = nwg % NXCD, xcd = wgid % NXCD, off = wgid / NXCD; wgid = (xcd < r ? xcd * (q + 1) : r * (q + 1) + (xcd - r) * q) + off; }
        const int nig = WGM * nN, gid = wgid / nig, fm = gid * WGM, gsz = (nM - fm) < WGM ? (nM - fm) : WGM;
        u.pm = fm + ((wgid % nig) % gsz); u.pn = (wgid % nig) / gsz; return true;
    }
    __device__ __forceinline__ void a_ready(const Unit&) const {}
    __device__ __forceinline__ void done(const Unit&) const {}
};

__device__ __forceinline__ unsigned cvt_pk_bf16(float lo, float hi) { unsigned r; asm volatile("v_cvt_pk_bf16_f32 %0, %1, %2" : "=v"(r) : "v"(lo), "v"(hi)); return r; }
typedef float f32x2 __attribute__((ext_vector_type(2)));
typedef unsigned u32x2 __attribute__((ext_vector_type(2)));
__device__ __forceinline__ float silu_f(float v) { return v / (1.f + __expf(-v)); }
__device__ __forceinline__ float gelu_tanh_f(float v) { const float u = 0.7978845608028654f * (v + 0.044715f * v * v * v); return v / (1.f + __expf(-2.f * u)); }
__device__ __forceinline__ float sigmoid_f(float v) { return 1.f / (1.f + __expf(-v)); }

struct EpiProj {
    static constexpr bool PERM = true, AFTER_DRAIN = false;
    bf16_t* O; float* vsum; float* vsq;
    __device__ __forceinline__ void operator()(const f32x4 (&acc)[2][2][4][2], const Unit& u, int wr, int wc, int fr, int fq) const {
        const int seg = u.pn >> 3;
        const int row0 = u.pm * BM + wr * 64 + fr, col0 = u.pn * BM + wc * 32 + 8 * fq;
#pragma unroll
        for (int ai = 0; ai < 2; ++ai)
#pragma unroll
            for (int m = 0; m < 4; ++m) { const int row = row0 + ai * HALF + m * 16; bf16_t* rowp = O + (size_t)row * 14336 + col0; float s1 = 0.f, s2 = 0.f;
#pragma unroll
                for (int bj = 0; bj < 2; ++bj) { f32x4 v0 = acc[ai][bj][m][0], v1 = acc[ai][bj][m][1];
                    if (seg == 3 || seg == 6) {
#pragma unroll
                        for (int e = 0; e < 4; ++e) { v0[e] = silu_f(v0[e]); v1[e] = silu_f(v1[e]); }
                    } else if (seg == 4 || seg == 5) {
#pragma unroll
                        for (int e = 0; e < 4; ++e) { v0[e] = gelu_tanh_f(v0[e]); v1[e] = gelu_tanh_f(v1[e]); }
                        if (seg == 5) {
#pragma unroll
                            for (int e = 0; e < 4; ++e) { s1 += v0[e] + v1[e]; s2 += v0[e] * v0[e] + v1[e] * v1[e]; } }
                    }
                    u32x4 w; w.x = cvt_pk_bf16(v0[0], v0[1]); w.y = cvt_pk_bf16(v0[2], v0[3]); w.z = cvt_pk_bf16(v1[0], v1[1]); w.w = cvt_pk_bf16(v1[2], v1[3]);
                    *(u32x4*)(rowp + bj * HALF) = w; }
                if (seg == 5) { s1 += __shfl_xor(s1, 16); s1 += __shfl_xor(s1, 32); s2 += __shfl_xor(s2, 16); s2 += __shfl_xor(s2, 32);
                    if (fq == 0) { atomicAdd(vsum + row, s1); atomicAdd(vsq + row, s2); } } }
    }
};
template <bool WB> struct EpiRes {
    static constexpr bool PERM = false, AFTER_DRAIN = false;
    const float* base; float* out; bf16_t* ob; float* ss;
    __device__ __forceinline__ void operator()(const f32x4 (&acc)[2][2][4][2], const Unit& u, int wr, int wc, int fr, int fq) const {
        const int row0 = u.pm * BM + wr * 64 + fr, col0 = u.pn * BM + wc * 32 + 4 * fq;
#pragma unroll
        for (int ai = 0; ai < 2; ++ai)
#pragma unroll
            for (int m = 0; m < 4; ++m) { const int row = row0 + ai * HALF + m * 16; const size_t off = (size_t)row * 2048 + col0; float s = 0.f;
#pragma unroll
                for (int bj = 0; bj < 2; ++bj)
#pragma unroll
                    for (int n = 0; n < 2; ++n) { const size_t o2 = off + bj * HALF + n * 16; const f32x4 b = *(const f32x4*)(base + o2); const f32x4 o = b + acc[ai][bj][m][n];
                        *(f32x4*)(out + o2) = o; s += (o[0] * o[0] + o[1] * o[1]) + (o[2] * o[2] + o[3] * o[3]);
                        if (WB) { u32x2 w; w.x = cvt_pk_bf16(o[0], o[1]); w.y = cvt_pk_bf16(o[2], o[3]); *(u32x2*)(ob + o2) = w; } }
                s += __shfl_xor(s, 16); s += __shfl_xor(s, 32);
                if (fq == 0) atomicAdd(ss + row, s); }
    }
};
struct EpiProj2 {
    static constexpr bool PERM = true, AFTER_DRAIN = false;
    bf16_t* O; const float* ss;
    __device__ __forceinline__ void operator()(const f32x4 (&acc)[2][2][4][2], const Unit& u, int wr, int wc, int fr, int fq) const {
        const int row0 = u.pm * BM + wr * 64 + fr, colt = u.pn * BM, col0 = colt + wc * 32 + 8 * fq;
#pragma unroll
        for (int ai = 0; ai < 2; ++ai)
#pragma unroll
            for (int m = 0; m < 4; ++m) { const int row = row0 + ai * HALF + m * 16; bf16_t* rowp = O + (size_t)row * 5376 + col0;
                const float rs = rsqrtf(ss[row] * (1.f / 2048.f) + 1e-6f);
#pragma unroll
                for (int bj = 0; bj < 2; ++bj) { f32x4 v0 = acc[ai][bj][m][0] * rs, v1 = acc[ai][bj][m][1] * rs;
                    if (colt + bj * HALF >= 2688) {
#pragma unroll
                        for (int e = 0; e < 4; ++e) { v0[e] = silu_f(v0[e]); v1[e] = silu_f(v1[e]); } }
                    u32x4 w; w.x = cvt_pk_bf16(v0[0], v0[1]); w.y = cvt_pk_bf16(v0[2], v0[3]); w.z = cvt_pk_bf16(v1[0], v1[1]); w.w = cvt_pk_bf16(v1[2], v1[3]);
                    *(u32x4*)(rowp + bj * HALF) = w; } }
    }
};
template <class Epi, class Sched, bool ALIGN_EPI = false, bool SP2 = false>
__device__ __forceinline__ void gemm_phase(PG8_LAS unsigned char* lds, const Gemm g, const Sched& S, const Epi& E) {
    const int tid = threadIdx.x, wid = __builtin_amdgcn_readfirstlane(tid >> 6), lane = tid & 63, wr = wid >> 2, wc = wid & 3, fr = lane & 15, fq = lane >> 4;
    const int K = g.K, nt = K / BK;
    unsigned voffA[2], voffB[2];
#pragma unroll
    for (int i = 0; i < 2; ++i) { int R, C; stage_rc(tid * 16 + i * 8192, R, C); const int Rb = Epi::PERM ? ((R & ~31) + perm32(R & 31)) : R;
        voffA[i] = (unsigned)(R * K + C) * 2u; voffB[i] = (unsigned)(Rb * K + C) * 2u; }
    const size_t kstep = (size_t)(BK * 2);
    const size_t hstep = (size_t)HALF * K * 2;
    const size_t tstep = 2 * hstep;
    const unsigned ldsw = (unsigned)wid * 1024u;
    const int aoff = lds_byte(wr * 64 + fr, fq * 8), boff = lds_byte(wc * 32 + fr, fq * 8);
#define PG8_SA(b, h) (((b) * 2 + (h)) * HTB)
#define PG8_SB(b, h) ((4 + (b) * 2 + (h)) * HTB)
#define PG8_STAGE(bufoff, gbase, voff) do { _Pragma("unroll") for (int _i = 0; _i < 2; ++_i) \
        __builtin_amdgcn_global_load_lds((const unsigned*)((const char*)(gbase) + (voff)[_i]), (PG8_LAS unsigned*)(lds + (bufoff) + ldsw + _i * 8192), 16, 0, 0); } while (0)
#define PG8_LDA(dst, b, h) do { _Pragma("unroll") for (int m = 0; m < 4; ++m) _Pragma("unroll") for (int k = 0; k < 2; ++k) dst[m][k] = *(const PG8_LAS bf16x8*)(lds + PG8_SA(b, h) + aoff + m * 2048 + k * 1024); } while (0)
#define PG8_LDB(dst, b, h) do { _Pragma("unroll") for (int n = 0; n < 2; ++n) _Pragma("unroll") for (int k = 0; k < 2; ++k) dst[n][k] = *(const PG8_LAS bf16x8*)(lds + PG8_SB(b, h) + boff + n * 2048 + k * 1024); } while (0)
#define PG8_MMA(ai, bj, At, Bt) do { __builtin_amdgcn_s_setprio(1); _Pragma("unroll") for (int m = 0; m < 4; ++m) _Pragma("unroll") for (int n = 0; n < 2; ++n) _Pragma("unroll") for (int k = 0; k < 2; ++k) \
        acc[ai][bj][m][n] = __builtin_amdgcn_mfma_f32_16x16x32_bf16(Bt[n][k], At[m][k], acc[ai][bj][m][n], 0, 0, 0); __builtin_amdgcn_s_setprio(0); } while (0)
#define PG8_WAIT_V(n) asm volatile("s_waitcnt vmcnt(" #n ")" ::: "memory")
#define PG8_WAIT_L(n) asm volatile("s_waitcnt lgkmcnt(" #n ")" ::: "memory")
#define PG8_BAR __builtin_amdgcn_s_barrier()
#define PG8_SCHED __builtin_amdgcn_sched_barrier(0)
    Unit cur, nxt; int ui = 0;
    if (!S.next(0, cur)) return;
    f32x4 acc[2][2][4][2];
#pragma unroll
    for (int a = 0; a < 2; ++a)
#pragma unroll
        for (int b = 0; b < 2; ++b)
#pragma unroll
            for (int m = 0; m < 4; ++m)
#pragma unroll
                for (int n = 0; n < 2; ++n) acc[a][b][m][n] = (f32x4){0.f, 0.f, 0.f, 0.f};
    bf16x8 At[4][2], B0[2][2], B1[2][2];
    const char* cA = (const char*)g.A + (size_t)cur.pm * tstep; const char* cB = (const char*)g.Bt + (size_t)cur.pn * tstep;
    S.a_ready(cur);
    if constexpr (SP2) {
        PG8_STAGE(PG8_SB(0, 0), cB, voffB); PG8_STAGE(PG8_SB(0, 1), cB + hstep, voffB); PG8_STAGE(PG8_SA(0, 0), cA, voffA); PG8_STAGE(PG8_SA(0, 1), cA + hstep, voffA);
        if (wr == 1) PG8_BAR;
        PG8_WAIT_V(2); PG8_BAR;
        PG8_STAGE(PG8_SB(1, 0), cB + kstep, voffB); PG8_STAGE(PG8_SA(1, 0), cA + kstep, voffA); PG8_STAGE(PG8_SB(1, 1), cB + hstep + kstep, voffB);
        PG8_WAIT_V(6); PG8_BAR;
    } else {
        PG8_STAGE(PG8_SB(0, 0), cB, voffB); PG8_STAGE(PG8_SA(0, 0), cA, voffA); PG8_STAGE(PG8_SB(0, 1), cB + hstep, voffB); PG8_STAGE(PG8_SA(0, 1), cA + hstep, voffA);
        if (wr == 1) PG8_BAR;
        PG8_WAIT_V(4); PG8_BAR;
        PG8_STAGE(PG8_SB(1, 0), cB + kstep, voffB); PG8_STAGE(PG8_SA(1, 0), cA + kstep, voffA); PG8_STAGE(PG8_SB(1, 1), cB + hstep + kstep, voffB);
        PG8_WAIT_V(6); PG8_BAR;
    }
    for (;;) {
        const bool has_next = S.next(ui + 1, nxt);
        const char* nA = has_next ? (const char*)g.A + (size_t)nxt.pm * tstep : cA; const char* nB = has_next ? (const char*)g.Bt + (size_t)nxt.pn * tstep : cB;
        for (int t = 0; t < nt; t += 2) {
            const bool last = (t == nt - 2);
            const char* a1 = cA + (size_t)(t + 1) * kstep;
            const char* a2 = last ? nA : cA + (size_t)(t + 2) * kstep; const char* b2 = last ? nB : cB + (size_t)(t + 2) * kstep;
            const char* a3 = a2 + kstep; const char* b3 = b2 + kstep;
            if (last && has_next) S.a_ready(nxt);
            if constexpr (SP2) {
            PG8_LDB(B0, 0, 0); PG8_LDB(B1, 0, 1); PG8_SCHED; PG8_LDA(At, 0, 0); PG8_STAGE(PG8_SA(1, 1), a1 + hstep, voffA);
            PG8_WAIT_V(8); PG8_WAIT_L(0); PG8_BAR; PG8_MMA(0, 0, At, B0); PG8_MMA(0, 1, At, B1); PG8_BAR; PG8_SCHED;
            PG8_LDA(At, 0, 1); PG8_STAGE(PG8_SB(0, 0), b2, voffB); PG8_STAGE(PG8_SB(0, 1), b2 + hstep, voffB); PG8_STAGE(PG8_SA(0, 0), a2, voffA);
            PG8_WAIT_V(8); PG8_WAIT_L(0); PG8_BAR; PG8_MMA(1, 0, At, B0); PG8_MMA(1, 1, At, B1); PG8_BAR; PG8_SCHED;
            PG8_LDB(B0, 1, 0); PG8_LDB(B1, 1, 1); PG8_SCHED; PG8_LDA(At, 1, 0); PG8_STAGE(PG8_SA(0, 1), a2 + hstep, voffA);
            PG8_WAIT_V(8); PG8_WAIT_L(0); PG8_BAR; PG8_MMA(0, 0, At, B0); PG8_MMA(0, 1, At, B1); PG8_BAR; PG8_SCHED;
            PG8_LDA(At, 1, 1); PG8_STAGE(PG8_SB(1, 0), b3, voffB); PG8_STAGE(PG8_SB(1, 1), b3 + hstep, voffB); PG8_STAGE(PG8_SA(1, 0), a3, voffA);
            PG8_WAIT_V(8); PG8_WAIT_L(0); PG8_BAR; PG8_MMA(1, 0, At, B0); PG8_MMA(1, 1, At, B1); PG8_BAR; PG8_SCHED;
            } else {
            PG8_LDB(B0, 0, 0); PG8_SCHED; PG8_LDA(At, 0, 0); PG8_STAGE(PG8_SA(1, 1), a1 + hstep, voffA);
            PG8_WAIT_L(8); PG8_BAR; PG8_WAIT_L(0); PG8_MMA(0, 0, At, B0); PG8_BAR; PG8_SCHED;
            PG8_LDB(B1, 0, 1); PG8_STAGE(PG8_SB(0, 0), b2, voffB);
            PG8_BAR; PG8_WAIT_L(0); PG8_MMA(0, 1, At, B1); PG8_BAR;
            PG8_LDA(At, 0, 1); PG8_STAGE(PG8_SA(0, 0), a2, voffA);
            PG8_BAR; PG8_WAIT_L(0); PG8_MMA(1, 0, At, B0); PG8_BAR; PG8_SCHED;
            PG8_STAGE(PG8_SB(0, 1), b2 + hstep, voffB);
            PG8_WAIT_V(6); PG8_BAR; PG8_MMA(1, 1, At, B1); PG8_BAR;
            PG8_LDB(B0, 1, 0); PG8_SCHED; PG8_LDA(At, 1, 0); PG8_STAGE(PG8_SA(0, 1), a2 + hstep, voffA);
            PG8_WAIT_L(8); PG8_BAR; PG8_WAIT_L(0); PG8_MMA(0, 0, At, B0); PG8_BAR; PG8_SCHED;
            PG8_LDB(B1, 1, 1); PG8_STAGE(PG8_SB(1, 0), b3, voffB);
            PG8_BAR; PG8_WAIT_L(0); PG8_MMA(0, 1, At, B1); PG8_BAR;
            PG8_LDA(At, 1, 1); PG8_STAGE(PG8_SA(1, 0), a3, voffA);
            PG8_BAR; PG8_WAIT_L(0); PG8_MMA(1, 0, At, B0); PG8_BAR; PG8_SCHED;
            PG8_STAGE(PG8_SB(1, 1), b3 + hstep, voffB);
            PG8_WAIT_V(6); PG8_BAR; PG8_MMA(1, 1, At, B1); PG8_BAR;
            }
        }
        if constexpr (ALIGN_EPI) { if (wr == 0) PG8_BAR; }
        if constexpr (!Epi::AFTER_DRAIN) { E(acc, cur, wr, wc, fr, fq); S.done(cur); }
        if (!has_next) break;
#pragma unroll
        for (int a = 0; a < 2; ++a)
#pragma unroll
            for (int b = 0; b < 2; ++b)
#pragma unroll
                for (int m = 0; m < 4; ++m)
#pragma unroll
                    for (int n = 0; n < 2; ++n) acc[a][b][m][n] = (f32x4){0.f, 0.f, 0.f, 0.f};
        cur = nxt; cA = nA; cB = nB; ++ui;
        if constexpr (ALIGN_EPI) { if (wr == 1) PG8_BAR; }
    }
    PG8_WAIT_V(0);
    if constexpr (!ALIGN_EPI) { if (wr == 0) PG8_BAR; }
    PG8_BAR;
    if constexpr (Epi::AFTER_DRAIN) { E.fused(acc, cur, wr, wc, fr, fq, lds, wid, lane); S.done(cur); }
#undef PG8_SA
#undef PG8_SB
#undef PG8_STAGE
#undef PG8_LDA
#undef PG8_LDB
#undef PG8_MMA
#undef PG8_WAIT_V
#undef PG8_WAIT_L
#undef PG8_BAR
#undef PG8_SCHED
}
}

#ifndef PG8_SP2
#define PG8_SP2 true
#endif
namespace att {
using bf16 = __hip_bfloat16;
using bf16x8 = __attribute__((ext_vector_type(8))) short;
using s16x4  = __attribute__((ext_vector_type(4))) short;
using f32x16 = __attribute__((ext_vector_type(16))) float;
using f32x4  = __attribute__((ext_vector_type(4))) float;
using u32x4  = __attribute__((ext_vector_type(4))) unsigned;
using u32x2  = __attribute__((ext_vector_type(2))) unsigned;
constexpr float SCALE = 0.088388347648318440f;
constexpr float THR = 8.f;
constexpr int LDP = 14336;
constexpr int SUB = 16384, BUFB = 4 * SUB, ATT_WS = 2 * BUFB;
#define KSWZ(row, colB) ((row) * 256 + ((colB) ^ (((row) & 7) << 4)))
#define SBAR() __builtin_amdgcn_sched_barrier(0)
__device__ __forceinline__ int crow(int r, int hi) { return (r & 3) + 8 * (r >> 2) + 4 * hi; }
__device__ __forceinline__ unsigned cvtpk(float lo, float hi) {
  unsigned r; asm volatile("v_cvt_pk_bf16_f32 %0, %1, %2" : "=v"(r) : "v"(lo), "v"(hi)); return r;
}
__device__ __forceinline__ void partialSM(f32x16& p0, f32x16& p1, float& m_reg, float& mn, float& alpha) {
  constexpr float C = SCALE * 1.4426950408889634f;
  float pmax = p0[0]; for (int r = 1; r < 16; ++r) pmax = fmaxf(pmax, p0[r]); for (int r = 0; r < 16; ++r) pmax = fmaxf(pmax, p1[r]);
  { auto rr = __builtin_amdgcn_permlane32_swap(__float_as_uint(pmax), __float_as_uint(pmax), false, false);
    pmax = fmaxf(__uint_as_float(rr[0]), __uint_as_float(rr[1])); }
  if (__builtin_expect(__all(pmax - m_reg <= THR / SCALE), 1)) { mn = m_reg; alpha = 1.f; }
  else { mn = fmaxf(m_reg, pmax); alpha = __builtin_amdgcn_exp2f((m_reg - mn) * C); m_reg = mn; }
  float mnC = -mn * C;
  for (int r = 0; r < 16; ++r) p0[r] = fmaf(p0[r], C, mnC); for (int r = 0; r < 16; ++r) p1[r] = fmaf(p1[r], C, mnC);
  for (int r = 0; r < 16; ++r) p0[r] = __builtin_amdgcn_exp2f(p0[r]);
}
__device__ __forceinline__ void finishSM(f32x16& p0, f32x16& p1, float alpha, float& l_reg, bf16x8& pa0, bf16x8& pa1, bf16x8& pa2, bf16x8& pa3) {
  for (int r = 0; r < 16; ++r) p1[r] = __builtin_amdgcn_exp2f(p1[r]);
  float ps = 0; for (int r = 0; r < 16; ++r) ps += p0[r]; for (int r = 0; r < 16; ++r) ps += p1[r];
  { auto rr = __builtin_amdgcn_permlane32_swap(__float_as_uint(ps), __float_as_uint(ps), false, false);
    ps = __uint_as_float(rr[0]) + __uint_as_float(rr[1]); }
  l_reg = l_reg * alpha + ps;
#define PK4(P, BASE, OUT) do { unsigned a0 = cvtpk(P[BASE + 0], P[BASE + 1]), a1 = cvtpk(P[BASE + 2], P[BASE + 3]);   \
    unsigned b0 = cvtpk(P[BASE + 4], P[BASE + 5]), b1 = cvtpk(P[BASE + 6], P[BASE + 7]);                              \
    auto r0 = __builtin_amdgcn_permlane32_swap(a0, b0, false, false); auto r1 = __builtin_amdgcn_permlane32_swap(a1, b1, false, false); \
    u32x4 w = {r0[0], r1[0], r0[1], r1[1]}; OUT = *reinterpret_cast<bf16x8*>(&w); } while (0)
  PK4(p0, 0, pa0); PK4(p0, 8, pa1); PK4(p1, 0, pa2); PK4(p1, 8, pa3);
#undef PK4
}
__device__ __forceinline__ void qkt(f32x16& p0, f32x16& p1, const bf16* Ks, const bf16x8* qr, int r32, int hi) {
  p0 = f32x16{}; p1 = f32x16{};
  for (int d0 = 0; d0 < 8; ++d0) { int cb = (d0 * 16 + hi * 8) * 2;
    bf16x8 b0 = *reinterpret_cast<const bf16x8*>((const char*)Ks + KSWZ(r32, cb));
    bf16x8 b1 = *reinterpret_cast<const bf16x8*>((const char*)Ks + KSWZ(32 + r32, cb));
    p0 = __builtin_amdgcn_mfma_f32_32x32x16_bf16(b0, qr[d0], p0, 0, 0, 0);
    p1 = __builtin_amdgcn_mfma_f32_32x32x16_bf16(b1, qr[d0], p1, 0, 0, 0); }
}
__device__ __forceinline__ int v_st(int k, int c) { const int kk = (k & ~0xC) | ((k & 4) << 1) | ((k & 8) >> 1); return ((kk >> 3) * 4 + (c >> 5)) * 512 + ((kk & 7) * 32 + (c & 31)) * 2; }
__device__ __forceinline__ int v_rd_base(int lane) { return ((lane & 3) << 3) | (((lane >> 2) & 3) << 6) | (((lane >> 4) & 1) << 5) | (((lane >> 5) & 1) << 8); }
constexpr int v_rd_off(int d0, int ks, int half) { return d0 * 512 + ks * 4096 + half * 2048; }
template <int OFF> __device__ __forceinline__ s16x4 tr_read(int vb) {
  s16x4 r; asm volatile("ds_read_b64_tr_b16 %0, %1 offset:%2" : "=&v"(r) : "v"(vb), "i"(OFF) : "memory"); return r;
}
template <int D0> __device__ __forceinline__ void pv_one(f32x16& od, int vb, bf16x8 pa0, bf16x8 pa1, bf16x8 pa2, bf16x8 pa3) {
  const s16x4 l0 = tr_read<v_rd_off(D0, 0, 0)>(vb), h0 = tr_read<v_rd_off(D0, 0, 1)>(vb), l1 = tr_read<v_rd_off(D0, 1, 0)>(vb), h1 = tr_read<v_rd_off(D0, 1, 1)>(vb);
  const s16x4 l2 = tr_read<v_rd_off(D0, 2, 0)>(vb), h2 = tr_read<v_rd_off(D0, 2, 1)>(vb), l3 = tr_read<v_rd_off(D0, 3, 0)>(vb), h3 = tr_read<v_rd_off(D0, 3, 1)>(vb);
  asm volatile("s_waitcnt lgkmcnt(0)" ::: "memory"); SBAR();
#define PK(L, H) (bf16x8){L[0], L[1], L[2], L[3], H[0], H[1], H[2], H[3]}
  od = __builtin_amdgcn_mfma_f32_32x32x16_bf16(pa0, PK(l0, h0), od, 0, 0, 0);
  od = __builtin_amdgcn_mfma_f32_32x32x16_bf16(pa1, PK(l1, h1), od, 0, 0, 0);
  od = __builtin_amdgcn_mfma_f32_32x32x16_bf16(pa2, PK(l2, h2), od, 0, 0, 0);
  od = __builtin_amdgcn_mfma_f32_32x32x16_bf16(pa3, PK(l3, h3), od, 0, 0, 0);
#undef PK
}
__device__ __forceinline__ void pv_d0(f32x16* o, int vb, bf16x8 pa0, bf16x8 pa1, bf16x8 pa2, bf16x8 pa3) {
  pv_one<0>(o[0], vb, pa0, pa1, pa2, pa3); pv_one<1>(o[1], vb, pa0, pa1, pa2, pa3); pv_one<2>(o[2], vb, pa0, pa1, pa2, pa3); pv_one<3>(o[3], vb, pa0, pa1, pa2, pa3);
}
__device__ __forceinline__ float bf2f(unsigned short s) { return __uint_as_float((unsigned)s << 16); }
__device__ __forceinline__ float wave_sum(float v) {
#pragma unroll
  for (int o = 1; o < 64; o <<= 1) v += __shfl_xor(v, o);
  return v;
}
__device__ __forceinline__ void attn_unit(int b, int h, int qc, const bf16* __restrict__ proj, bf16* __restrict__ ymix, float lam, const float* __restrict__ hnorm, char* lds) {
  const int tid = threadIdx.x, wid = __builtin_amdgcn_readfirstlane(tid >> 6), lane = tid & 63, r32 = lane & 31, hi = lane >> 5;
  const int rg = wid & 1, map = (wid >> 1) & 1, vh = wid >> 2;
  float* ws = (float*)(lds + ATT_WS) + wid * 64; float* li_l = ws; float* al_l = ws + 32;
  const long rowbase = (long)b * 4096;
  const bf16* Kg = proj + rowbase * LDP + 2048 + h * 256;
  const bf16* Vg = proj + rowbase * LDP + 4096 + h * 256;
  const bf16* Qw = proj + (rowbase + qc * 64 + rg * 32 + r32) * LDP + h * 256 + map * 128 + hi * 8;
  float m_reg = -1e30f, l_reg = 0; f32x16 o[4] = {}; bf16x8 qr[8];
#pragma unroll
  for (int d0 = 0; d0 < 8; ++d0) qr[d0] = *reinterpret_cast<const bf16x8*>(Qw + d0 * 16);
  const int sr = tid >> 4, sc = (tid & 15) * 8, vst0 = v_st(sr, sc), vst1 = v_st(32 + sr, sc), kst0 = KSWZ(sr, sc * 2), kst1 = KSWZ(32 + sr, sc * 2);
  const int vb0 = (int)(uintptr_t)lds + 2 * SUB + vh * SUB + v_rd_base(lane);
  const bf16* Kt0 = (const bf16*)(lds + map * SUB);
  bf16x8 s0, s1, s2, s3, s4, s5, s6, s7;
#define SLOAD(k0) do { const bf16* kp = Kg + (long)((k0) + sr) * LDP + sc; const bf16* vp = Vg + (long)((k0) + sr) * LDP + sc; \
    s0 = *(const bf16x8*)kp; s1 = *(const bf16x8*)(kp + 32L * LDP); s2 = *(const bf16x8*)(kp + 128); s3 = *(const bf16x8*)(kp + 32L * LDP + 128); \
    s4 = *(const bf16x8*)vp; s5 = *(const bf16x8*)(vp + 32L * LDP); s6 = *(const bf16x8*)(vp + 128); s7 = *(const bf16x8*)(vp + 32L * LDP + 128); } while (0)
#define SWRITE(bf) do { char* bb = lds + (bf) * BUFB; *(bf16x8*)(bb + kst0) = s0; *(bf16x8*)(bb + kst1) = s1; *(bf16x8*)(bb + SUB + kst0) = s2; *(bf16x8*)(bb + SUB + kst1) = s3; \
    *(bf16x8*)(bb + 2 * SUB + vst0) = s4; *(bf16x8*)(bb + 2 * SUB + vst1) = s5; *(bf16x8*)(bb + 3 * SUB + vst0) = s6; *(bf16x8*)(bb + 3 * SUB + vst1) = s7; } while (0)
#define SWAIT() asm volatile("s_waitcnt vmcnt(0)" ::: "memory")
#define RESC(a) do { if (__any((a) < 1.f)) { if (hi == 0) al_l[r32] = (a); asm volatile("s_waitcnt lgkmcnt(0)" ::: "memory"); \
    for (int d = 0; d < 4; ++d) for (int r = 0; r < 16; ++r) o[d][r] *= al_l[crow(r, hi)]; } } while (0)
  f32x16 p0, p1; float mn, al; bf16x8 pa0, pa1, pa2, pa3; const int NT = qc + 1;
  SLOAD(0); SWAIT(); SWRITE(0); __syncthreads();
  for (int j = 0; j < NT; ++j) {
    const int bo = (j & 1) * BUFB; const bool more = (j + 1 < NT);
    if (more) SLOAD((j + 1) * 64);
    SBAR(); qkt(p0, p1, (const bf16*)((const char*)Kt0 + bo), qr, r32, hi);
    partialSM(p0, p1, m_reg, mn, al); RESC(al);
    finishSM(p0, p1, al, l_reg, pa0, pa1, pa2, pa3); SBAR();
    pv_d0(o, vb0 + bo, pa0, pa1, pa2, pa3);
    if (more) { SWAIT(); SWRITE((j + 1) & 1); }
    __syncthreads();
  }
  if (hi == 0) li_l[r32] = l_reg;
  __syncthreads();
  { float* Ob = (float*)lds + wid * 4096;
#pragma unroll
    for (int r = 0; r < 16; ++r) { const int orow = crow(r, hi);
#pragma unroll
      for (int d0 = 0; d0 < 4; ++d0) Ob[orow * 128 + d0 * 32 + r32] = o[d0][r]; } }
  __syncthreads();
  const float* lall = (const float*)(lds + ATT_WS);
#pragma unroll 1
  for (int rr = 0; rr < 8; ++rr) {
    const int row = wid * 8 + rr, rg2 = row >> 5, r5 = row & 31, c = lane * 4, vh2 = c >> 7, cc = c & 127, w1 = rg2 + 4 * vh2;
    const float* O1 = (const float*)lds + w1 * 4096 + r5 * 128 + cc;
    const float il1 = 1.f / lall[w1 * 64 + r5], il2 = lam / lall[(w1 + 2) * 64 + r5];
    const f32x4 a = *(const f32x4*)O1 * il1, b2 = *(const f32x4*)(O1 + 2 * 4096) * il2;
    const f32x4 d = a - b2;
    const float ssq = wave_sum((d[0] * d[0] + d[1] * d[1]) + (d[2] * d[2] + d[3] * d[3]));
    const float rstd = rsqrtf(ssq * (1.f / 256.f) + 1e-6f) * 0.8f;
    const f32x4 g = *(const f32x4*)(hnorm + h * 256 + c);
    const long grow = rowbase + qc * 64 + row;
    const u32x2 zz = *(const u32x2*)(proj + grow * LDP + 6144 + h * 256 + c);
    const float z0 = __uint_as_float(zz.x << 16), z1 = __uint_as_float(zz.x & 0xffff0000u), z2 = __uint_as_float(zz.y << 16), z3 = __uint_as_float(zz.y & 0xffff0000u);
    u32x2 w; w.x = cvtpk(d[0] * rstd * g[0] * z0, d[1] * rstd * g[1] * z1); w.y = cvtpk(d[2] * rstd * g[2] * z2, d[3] * rstd * g[3] * z3);
    *(u32x2*)(ymix + grow * 4096 + h * 256 + c) = w;
  }
  __syncthreads();
#undef SLOAD
#undef SWRITE
#undef SWAIT
#undef RESC
}
__device__ __forceinline__ void sgu_unit(int n, int g, const bf16* __restrict__ proj, bf16* __restrict__ ymix, const bf16* __restrict__ Wsb, const float* __restrict__ vsum, const float* __restrict__ vsq,
                                         const float* __restrict__ ln_g, const float* __restrict__ ln_b, const float* __restrict__ b_s, char* lds) {
  const int tid = threadIdx.x, wid = __builtin_amdgcn_readfirstlane(tid >> 6), lane = tid & 63, r32 = lane & 31, hi = lane >> 5;
  unsigned short* vT = (unsigned short*)lds;
  float* mean_l = (float*)(lds + 256 * 136 * 2); float* rstd_l = mean_l + 128;
  const long t0 = (long)n * 128; const int c0 = g * 256;
  if (tid < 128) { const float m = vsum[t0 + tid] * (1.f / 2048.f); const float var = vsq[t0 + tid] * (1.f / 2048.f) - m * m; mean_l[tid] = m; rstd_l[tid] = rsqrtf(fmaxf(var, 0.f) + 1e-6f); }
  __syncthreads();
#pragma unroll 2
  for (int k = 0; k < 8; ++k) { const int item = tid + 512 * k, t = item >> 5, c = (item & 31) * 8;
    const u32x4 raw = *(const u32x4*)(proj + (t0 + t) * LDP + 10240 + c0 + c);
    const f32x4 g0 = *(const f32x4*)(ln_g + c0 + c), g1 = *(const f32x4*)(ln_g + c0 + c + 4), b0 = *(const f32x4*)(ln_b + c0 + c), b1 = *(const f32x4*)(ln_b + c0 + c + 4);
    const float mu = mean_l[t], rs = rstd_l[t];
    float v[8] = {__uint_as_float(raw.x << 16), __uint_as_float(raw.x & 0xffff0000u), __uint_as_float(raw.y << 16), __uint_as_float(raw.y & 0xffff0000u),
                  __uint_as_float(raw.z << 16), __uint_as_float(raw.z & 0xffff0000u), __uint_as_float(raw.w << 16), __uint_as_float(raw.w & 0xffff0000u)};
#pragma unroll
    for (int e = 0; e < 8; ++e) { const float gg = e < 4 ? g0[e & 3] : g1[e & 3], bb = e < 4 ? b0[e & 3] : b1[e & 3];
      const float val = (v[e] - mu) * rs * gg + bb; vT[(c + e) * 136 + t] = (unsigned short)(cvtpk(val, 0.f) & 0xffffu); } }
  __syncthreads();
  f32x16 acc[4] = {};
#pragma unroll 2
  for (int ks = 0; ks < 8; ++ks) { const bf16x8 B = *(const bf16x8*)(vT + (32 * wid + r32) * 136 + ks * 16 + hi * 8);
#pragma unroll
    for (int m = 0; m < 4; ++m) { const bf16x8 A = *(const bf16x8*)(Wsb + g * 16384 + (32 * m + r32) * 128 + ks * 16 + hi * 8);
      acc[m] = __builtin_amdgcn_mfma_f32_32x32x16_bf16(A, B, acc[m], 0, 0, 0); } }
  const int c = c0 + 32 * wid + r32;
#pragma unroll
  for (int m = 0; m < 4; ++m)
#pragma unroll
    for (int r = 0; r < 16; ++r) { const int i = 32 * m + crow(r, hi); const long row = t0 + i;
      const float mixed = acc[m][r] + b_s[g * 128 + i];
      const float u = bf2f(*(const unsigned short*)(proj + row * LDP + 8192 + c)), sz = bf2f(*(const unsigned short*)(proj + row * LDP + 12288 + c));
      *(unsigned short*)(ymix + row * 4096 + 2048 + c) = (unsigned short)(cvtpk(u * mixed * sz, 0.f) & 0xffffu);
      if ((r & 3) == 3) asm volatile("" ::: "memory"); }
  __syncthreads();
}
}
#define LAS __attribute__((address_space(3)))
typedef unsigned short bf16;
typedef unsigned v4u __attribute__((ext_vector_type(4)));
typedef unsigned v2u __attribute__((ext_vector_type(2)));
typedef float f32x4 __attribute__((ext_vector_type(4)));
typedef float f32x16 __attribute__((ext_vector_type(16)));
typedef short bf16x8 __attribute__((ext_vector_type(8)));
constexpr int NWAVES = 8;
constexpr int M = 8192, DM = 2048, SEQ = 4096, NIN = 14336, NMIX = 4096, CW = 2688, NCIN = 5376;
constexpr size_t MiB = 1u << 20;
constexpr size_t WS_STATS = 0;
constexpr size_t WS_SUMA = 1 * MiB, WS_SUMH = 3 * MiB;
constexpr size_t WS_WGT = 5 * MiB;
constexpr size_t WS_WSB = 8 * MiB;
constexpr size_t WS_WTOUT = 9 * MiB;
constexpr size_t WS_WTCIN = 25 * MiB;
constexpr size_t WS_WTCOUT = 46 * MiB;
constexpr size_t WS_WTIN = 57 * MiB;
constexpr size_t WS_XN = 113 * MiB;
constexpr size_t WS_YMIX = 57 * MiB, WS_YMIX2 = 57 * MiB;
constexpr size_t WS_PROJ = 145 * MiB;
constexpr size_t WS_X1B = 145 * MiB;
constexpr size_t WS_PROJ2 = 177 * MiB;
constexpr size_t WS_HL = 261 * MiB, WS_PP = 303 * MiB;
constexpr size_t WS_END = 369 * MiB;
constexpr int LDS_BYTES = 147456;

__device__ __forceinline__ unsigned f2bf(float f) { unsigned u = __builtin_bit_cast(unsigned, f); return (u + 0x7fffu + ((u >> 16) & 1u)) >> 16; }
__device__ __forceinline__ unsigned pk2(float lo, float hi) { return f2bf(lo) | (f2bf(hi) << 16); }
__device__ __forceinline__ float bf2f(unsigned short s) { return __uint_as_float((unsigned)s << 16); }
__device__ __forceinline__ float wave_sum(float v) {
#pragma unroll
    for (int o = 1; o < 64; o <<= 1) v += __shfl_xor(v, o);
    return v;
}
__device__ __forceinline__ int crow(int r, int hi) { return (r & 3) + 8 * (r >> 2) + 4 * hi; }

__device__ __forceinline__ void p0_transpose_item(const float* __restrict__ W, int K, int N, bf16* __restrict__ WT, const float* __restrict__ kscale, float* scr, int item, int lane) {
    const int nblk = N / 32, kb = item / nblk, nb = item % nblk, k0 = 64 * kb, n0 = 32 * nb;
#pragma unroll 8
    for (int i = 0; i < 32; ++i) { const int kk = 2 * i + (lane >> 5); float v = W[(size_t)(k0 + kk) * N + n0 + (lane & 31)]; if (kscale) v *= kscale[k0 + kk]; scr[kk * 33 + (lane & 31)] = v; }
    asm volatile("s_waitcnt lgkmcnt(0)" ::: "memory");
    const int c = lane & 7;
#pragma unroll
    for (int j = 0; j < 4; ++j) { const int n = (lane >> 3) + 8 * j; const float* s = scr + (8 * c) * 33 + n;
        v4u o; o.x = pk2(s[0 * 33], s[1 * 33]); o.y = pk2(s[2 * 33], s[3 * 33]); o.z = pk2(s[4 * 33], s[5 * 33]); o.w = pk2(s[6 * 33], s[7 * 33]);
        *(v4u*)(WT + (size_t)(n0 + n) * K + k0 + 8 * c) = o; }
    asm volatile("s_waitcnt lgkmcnt(0)" ::: "memory");
}

struct Args { const float* in[21]; float* out; unsigned char* ws; int ph_lo, ph_hi; };

__device__ __forceinline__ void lru_unit(int b, int hd, int tc, const bf16* __restrict__ proj2, const bf16* __restrict__ WgT, const float* __restrict__ conv_w, const float* __restrict__ conv_b,
                                         const float* __restrict__ b_a, const float* __restrict__ b_x, const float* __restrict__ lam, bf16* __restrict__ HL, bf16* __restrict__ PP,
                                         float* __restrict__ sumA, float* __restrict__ sumH, char* lds) {
    const int tid = threadIdx.x, wid = __builtin_amdgcn_readfirstlane(tid >> 6), lane = tid & 63, r32 = lane & 31, hi = lane >> 5;
    bf16* xcb = (bf16*)lds;
    float* abuf = (float*)(lds + 25600);
    float* bbuf = abuf + 64 * 168;
    float* segA = bbuf + 64 * 168;
    float* segH = segA + 3 * 168;
    const long row0 = (long)b * SEQ + tc * 64;
    for (int idx = tid; idx < 64 * 32; idx += 512) xcb[(idx >> 5) * 200 + 168 + (idx & 31)] = 0;
    for (int it = tid; it < 64 * 168; it += 512) { const int t = it / 168, c = it - t * 168, C = hd * 168 + c, tl = tc * 64 + t;
        float acc = conv_b[C];
#pragma unroll
        for (int k = 0; k < 4; ++k) { const int tt = tl - 3 + k; if (tt >= 0) acc += conv_w[k * CW + C] * bf2f(proj2[((long)b * SEQ + tt) * NCIN + C]); }
        xcb[t * 200 + c] = (bf16)f2bf(acc); bbuf[it] = acc; }
    __syncthreads();
    for (int item = wid; item < 12; item += 8) { const int m = item & 1, n = item >> 1;
        f32x16 accr = {}, acci = {};
        const bf16* wr_ = WgT + ((size_t)(hd * 2 + 0) * 192 + 32 * n + r32) * 192 + hi * 8; const bf16* wi_ = wr_ + 192 * 192;
#pragma unroll
        for (int ks = 0; ks < 12; ++ks) { const bf16x8 A = *(const bf16x8*)(xcb + (32 * m + r32) * 200 + ks * 16 + hi * 8);
            const bf16x8 Br = *(const bf16x8*)(wr_ + ks * 16), Bi = *(const bf16x8*)(wi_ + ks * 16);
            accr = __builtin_amdgcn_mfma_f32_32x32x16_bf16(A, Br, accr, 0, 0, 0); acci = __builtin_amdgcn_mfma_f32_32x32x16_bf16(A, Bi, acci, 0, 0, 0); }
        const int j = 32 * n + r32;
        if (j < 168) { const int C = hd * 168 + j; const float ba = b_a[C], bx = b_x[C], sp = log1pf(__expf(-lam[C]));
#pragma unroll
            for (int r = 0; r < 16; ++r) { const int t = 32 * m + crow(r, hi);
                const float rg = 1.f / (1.f + __expf(-(accr[r] + ba))), ig = 1.f / (1.f + __expf(-(acci[r] + bx)));
                const float la = -8.f * rg * sp, a = __expf(la), beta = sqrtf(-expm1f(2.f * la));
                const float xv = bbuf[t * 168 + j]; abuf[t * 168 + j] = a; bbuf[t * 168 + j] = beta * ig * xv; } }
    }
    __syncthreads();
    if (tid < 504) { const int seg = tid / 168, c = tid - seg * 168; const int t0 = seg == 0 ? 0 : (seg == 1 ? 22 : 43), t1 = seg == 0 ? 22 : (seg == 1 ? 43 : 64);
        float P = 1.f, h = 0.f;
        for (int t = t0; t < t1; ++t) { const float a = abuf[t * 168 + c], bb = bbuf[t * 168 + c]; h = a * h + bb; P *= a; abuf[t * 168 + c] = P; bbuf[t * 168 + c] = h; }
        segA[seg * 168 + c] = P; segH[seg * 168 + c] = h; }
    __syncthreads();
    for (int it = tid; it < 64 * 168; it += 512) { const int t = it / 168, c = it - t * 168, C = hd * 168 + c;
        float Pin = 1.f, Hin = 0.f;
        if (t >= 43) { Pin = segA[c] * segA[168 + c]; Hin = segA[168 + c] * segH[c] + segH[168 + c]; } else if (t >= 22) { Pin = segA[c]; Hin = segH[c]; }
        const float hl = bbuf[it] + abuf[it] * Hin, P = abuf[it] * Pin;
        HL[(row0 + t) * CW + C] = (bf16)f2bf(hl); PP[(row0 + t) * CW + C] = (bf16)f2bf(P);
        if (t == 63) { sumA[(size_t)(b * 64 + tc) * CW + C] = P; sumH[(size_t)(b * 64 + tc) * CW + C] = hl; } }
    __syncthreads();
}
__device__ __forceinline__ void carry_unit(int u, const bf16* __restrict__ HL, const bf16* __restrict__ PP, const bf16* __restrict__ proj2, const float* __restrict__ sumA, const float* __restrict__ sumH,
                                           bf16* __restrict__ ymix2, char* lds) {
    const int tid = threadIdx.x; const int chunk = u >> 1, half = u & 1, b = chunk >> 6, cbase = half * 1344;
    float* carry = (float*)lds;
    for (int c = tid; c < 1344; c += 512) { const int C = cbase + c; float h = 0.f;
#pragma unroll 8
        for (int cc = b * 64; cc < chunk; ++cc) h = sumA[(size_t)cc * CW + C] * h + sumH[(size_t)cc * CW + C];
        carry[c] = h; }
    __syncthreads();
    for (int it = tid; it < 64 * 168; it += 512) { const int t = it / 168, v = it - t * 168; const long row = (long)chunk * 64 + t; const int C = cbase + v * 8;
        const v4u hl = *(const v4u*)(HL + row * CW + C), pp = *(const v4u*)(PP + row * CW + C), sz = *(const v4u*)(proj2 + row * NCIN + CW + C);
        const f32x4 c0 = *(const f32x4*)(carry + v * 8), c1 = *(const f32x4*)(carry + v * 8 + 4);
        v4u o;
#define LO(x) __uint_as_float((x) << 16)
#define HI(x) __uint_as_float((x) & 0xffff0000u)
        o.x = pk2((LO(hl.x) + LO(pp.x) * c0[0]) * LO(sz.x), (HI(hl.x) + HI(pp.x) * c0[1]) * HI(sz.x));
        o.y = pk2((LO(hl.y) + LO(pp.y) * c0[2]) * LO(sz.y), (HI(hl.y) + HI(pp.y) * c0[3]) * HI(sz.y));
        o.z = pk2((LO(hl.z) + LO(pp.z) * c1[0]) * LO(sz.z), (HI(hl.z) + HI(pp.z) * c1[1]) * HI(sz.z));
        o.w = pk2((LO(hl.w) + LO(pp.w) * c1[2]) * LO(sz.w), (HI(hl.w) + HI(pp.w) * c1[3]) * HI(sz.w));
#undef LO
#undef HI
        *(v4u*)(ymix2 + row * CW + C) = o; }
    __syncthreads();
}

__global__ void __launch_bounds__(NWAVES * 64, 2) mk_fwd(Args args) {
    extern __shared__ __attribute__((aligned(16))) unsigned char lds[];
    const int tid = threadIdx.x, lane = tid & 63, wave = __builtin_amdgcn_readfirstlane(tid >> 6);
    const int G = gridDim.x; const int bx = blockIdx.x; const int vcu = (G % 8 == 0) ? (bx % 8) * (G / 8) + bx / 8 : bx;
    typedef const float* cfp; typedef __attribute__((address_space(4))) const volatile unsigned long long* kaq;
    const kaq kap = (kaq)__builtin_amdgcn_kernarg_segment_ptr();
#define KIN(i) ((cfp)(kap[(i)]))
    unsigned char* ws = (unsigned char*)(kap[22]);
#define K_x KIN(0)
#define K_ab_norm KIN(1)
#define K_ab_w_in KIN(2)
#define K_ab_lambda KIN(3)
#define K_ab_head_norm KIN(4)
#define K_sgu_ln_g KIN(5)
#define K_sgu_ln_b KIN(6)
#define K_sgu_w KIN(7)
#define K_sgu_b KIN(8)
#define K_ab_w_out KIN(9)
#define K_c_norm KIN(10)
#define K_c_w_in KIN(11)
#define K_c_conv_w KIN(12)
#define K_c_conv_b KIN(13)
#define K_c_gate_a_w KIN(14)
#define K_c_gate_a_b KIN(15)
#define K_c_gate_x_w KIN(16)
#define K_c_gate_x_b KIN(17)
#define K_c_lambda KIN(18)
#define K_c_w_out KIN(19)
#define K_final_norm KIN(20)
#define K_out ((float*)(kap[21]))
    float* ss1 = (float*)(ws + WS_STATS); float* ss2 = ss1 + M; float* vsum = ss2 + M; float* vsq = vsum + M;
    float* sumA = (float*)(ws + WS_SUMA); float* sumH = (float*)(ws + WS_SUMH);
    bf16* WgT = (bf16*)(ws + WS_WGT); bf16* Wsb = (bf16*)(ws + WS_WSB);
    bf16* WtOut = (bf16*)(ws + WS_WTOUT); bf16* WtCin = (bf16*)(ws + WS_WTCIN); bf16* WtCout = (bf16*)(ws + WS_WTCOUT); bf16* WtIn = (bf16*)(ws + WS_WTIN);
    bf16* XN = (bf16*)(ws + WS_XN); bf16* YMIX = (bf16*)(ws + WS_YMIX); bf16* YMIX2 = (bf16*)(ws + WS_YMIX2); bf16* PROJ = (bf16*)(ws + WS_PROJ);
    bf16* X1B = (bf16*)(ws + WS_X1B); bf16* PROJ2 = (bf16*)(ws + WS_PROJ2); bf16* HL = (bf16*)(ws + WS_HL); bf16* PP = (bf16*)(ws + WS_PP);
    const int lo = args.ph_lo, hi = args.ph_hi;
#ifndef PH_MASK
#define PH_MASK 0x1ff
#endif
#define IN(k) (((PH_MASK >> (k)) & 1) && lo <= (k) && (k) < hi)
#if MK_N_LAUNCHES == 1
#define SEAM(k) do { if (IN(k) && IN((k) + 1)) { cg::this_grid().sync(); } } while (0)
#else
#define SEAM(k) do { } while (0)
#endif
    const int gw = vcu * NWAVES + wave, NGW = G * NWAVES; const int gt = bx * 512 + tid, NGT = G * 512;

    if (IN(0)) {
        for (int i = gt; i < 4 * M; i += NGT) ss1[i] = 0.f;
        float* scr = (float*)(lds + wave * 16384);
        constexpr int I_IN = (DM / 64) * (NIN / 32), I_OUT = (NMIX / 64) * (DM / 32), I_CIN = (DM / 64) * (NCIN / 32), I_COUT = (CW / 64) * (DM / 32);
        for (int it = gw; it < I_IN + I_OUT + I_CIN + I_COUT; it += NGW) {
            int r = it;
            if (r < I_IN) { p0_transpose_item(K_ab_w_in, DM, NIN, WtIn, nullptr, scr, r, lane); continue; } r -= I_IN;
            if (r < I_OUT) { p0_transpose_item(K_ab_w_out, NMIX, DM, WtOut, nullptr, scr, r, lane); continue; } r -= I_OUT;
            if (r < I_CIN) { p0_transpose_item(K_c_w_in, DM, NCIN, WtCin, K_c_norm, scr, r, lane); continue; } r -= I_CIN;
            p0_transpose_item(K_c_w_out, CW, DM, WtCout, nullptr, scr, r, lane);
        }
        for (int i = gt; i < 16 * 2 * 192 * 192; i += NGT) { const int ii = i % 192, j = (i / 192) % 192, gate = (i / (192 * 192)) & 1, hd = i / (2 * 192 * 192);
            float v = 0.f; if (ii < 168 && j < 168) v = (gate ? K_c_gate_x_w : K_c_gate_a_w)[((size_t)hd * 168 + ii) * 168 + j];
            WgT[i] = (bf16)f2bf(v); }
        for (int i = gt; i < 8 * 128 * 128; i += NGT) { const int j = i & 127, ii = (i >> 7) & 127; Wsb[i] = ((ii >> 6) >= (j >> 6)) ? (bf16)f2bf(K_sgu_w[i]) : (bf16)0; }
        const float* x_ = K_x; const float* abn_ = K_ab_norm;
        for (int m = gw; m < M; m += NGW) {
            const f32x4* xr = (const f32x4*)(x_ + (size_t)m * DM) + lane; f32x4 v[8]; float s = 0.f;
#pragma unroll
            for (int j = 0; j < 8; ++j) { v[j] = xr[64 * j]; s += (v[j][0] * v[j][0] + v[j][1] * v[j][1]) + (v[j][2] * v[j][2] + v[j][3] * v[j][3]); }
            const float rs = rsqrtf(wave_sum(s) * (1.f / DM) + 1e-6f);
            unsigned long long* o8 = (unsigned long long*)(XN + (size_t)m * DM) + lane;
#pragma unroll
            for (int j = 0; j < 8; ++j) { const f32x4 g = ((const f32x4*)abn_)[lane + 64 * j];
                o8[64 * j] = (unsigned long long)pk2(v[j][0] * rs * g[0], v[j][1] * rs * g[1]) | ((unsigned long long)pk2(v[j][2] * rs * g[2], v[j][3] * rs * g[3]) << 32); }
        }
        __syncthreads();
    }
    SEAM(0);
    if (IN(1)) {
        pg8::Gemm g{XN, WtIn, M, NIN, DM}; pg8::StaticOrder S; S.init(M, NIN, G, bx);
        pg8::EpiProj E{PROJ, vsum, vsq};
        pg8::gemm_phase<pg8::EpiProj, pg8::StaticOrder, true, true>((LAS unsigned char*)lds, g, S, E);
    }
    SEAM(1);
    if (IN(2)) {
        float lam;
        { const float a0 = K_ab_lambda[lane] * K_ab_lambda[128 + lane] + K_ab_lambda[64 + lane] * K_ab_lambda[192 + lane];
          const float a1 = K_ab_lambda[256 + lane] * K_ab_lambda[384 + lane] + K_ab_lambda[320 + lane] * K_ab_lambda[448 + lane];
          lam = __expf(wave_sum(a0)) - __expf(wave_sum(a1)) + 0.2f; }
#ifndef NO_ATT
        for (int p = vcu; p < 512; p += G) { const int bh = p >> 5, s = p & 31;
#pragma unroll 1
            for (int k = 0; k < 2; ++k) att::attn_unit(bh >> 3, bh & 7, k ? s : 63 - s, (const att::bf16*)PROJ, (att::bf16*)YMIX, lam, K_ab_head_norm, (char*)lds); }
#endif
#ifndef NO_SGU
        for (int u = vcu; u < 512; u += G) att::sgu_unit(u >> 3, u & 7, (const att::bf16*)PROJ, (att::bf16*)YMIX, (const att::bf16*)Wsb, vsum, vsq, K_sgu_ln_g, K_sgu_ln_b, K_sgu_b, (char*)lds);
#endif
    }
    SEAM(2);
    if (IN(3)) {
        pg8::Gemm g{YMIX, WtOut, M, DM, NMIX}; pg8::StaticOrder S; S.init(M, DM, G, bx);
        pg8::EpiRes<true> E{K_x, K_out, X1B, ss1};
        pg8::gemm_phase<pg8::EpiRes<true>, pg8::StaticOrder, true, true>((LAS unsigned char*)lds, g, S, E);
    }
    SEAM(3);
    if (IN(4)) {
        pg8::Gemm g{X1B, WtCin, M, NCIN, DM}; pg8::StaticOrder S; S.init(M, NCIN, G, bx);
        pg8::EpiProj2 E{PROJ2, ss1};
        pg8::gemm_phase<pg8::EpiProj2, pg8::StaticOrder, true, true>((LAS unsigned char*)lds, g, S, E);
    }
    SEAM(4);
    if (IN(5)) {
        for (int u = vcu; u < 2048; u += G) { const int bh = u >> 6, tc = u & 63;
            lru_unit(bh >> 4, bh & 15, tc, PROJ2, WgT, K_c_conv_w, K_c_conv_b, K_c_gate_a_b, K_c_gate_x_b, K_c_lambda, HL, PP, sumA, sumH, (char*)lds); }
    }
    SEAM(5);
    if (IN(6)) {
        for (int u = vcu; u < 256; u += G) carry_unit(u, HL, PP, PROJ2, sumA, sumH, YMIX2, (char*)lds);
    }
    SEAM(6);
    if (IN(7)) {
        pg8::Gemm g{YMIX2, WtCout, M, DM, CW}; pg8::StaticOrder S; S.init(M, DM, G, bx);
        pg8::EpiRes<false> E{K_out, K_out, nullptr, ss2};
        pg8::gemm_phase<pg8::EpiRes<false>, pg8::StaticOrder, true, true>((LAS unsigned char*)lds, g, S, E);
    }
    SEAM(7);
    if (IN(8)) {
        for (int m = gw; m < M; m += NGW) { f32x4* xr = (f32x4*)(K_out + (size_t)m * DM) + lane; const float rs = rsqrtf(ss2[m] * (1.f / DM) + 1e-6f);
#pragma unroll
            for (int j = 0; j < 8; ++j) { const f32x4 g = ((const f32x4*)K_final_norm)[lane + 64 * j]; f32x4 v = xr[64 * j]; v = v * rs * g; xr[64 * j] = v; } }
    }
#undef IN
#undef SEAM
}

extern "C" void kernel_launch(void* const* d_in, const int* in_sizes, int n_in, void* d_out, int out_size, void* d_ws, size_t ws_size, hipStream_t stream) {
    static int grid = 0;
    if (grid == 0) {
        if (n_in != 21 || out_size != M * DM || ws_size < WS_END) { fprintf(stderr, "kernel_launch: unexpected shapes (n_in %d out %d ws %zu)\n", n_in, out_size, ws_size); grid = -1; return; }
        int dev = 0, cus = 0, per_cu = 0;
        (void)hipGetDevice(&dev); (void)hipDeviceGetAttribute(&cus, hipDeviceAttributeMultiprocessorCount, dev);
        if (hipFuncSetAttribute((const void*)mk_fwd, hipFuncAttributeMaxDynamicSharedMemorySize, LDS_BYTES) != hipSuccess) { fprintf(stderr, "kernel_launch: hipFuncSetAttribute failed\n"); grid = -1; return; }
        (void)hipOccupancyMaxActiveBlocksPerMultiprocessor(&per_cu, (const void*)mk_fwd, NWAVES * 64, LDS_BYTES);
        (void)hipGetLastError();
        if (per_cu < 1) { fprintf(stderr, "kernel_launch: occupancy query says %d blocks per CU\n", per_cu); per_cu = 1; }
        grid = cus;
    }
    if (grid < 0) return;
    Args a{};
    for (int i = 0; i < 21; ++i) a.in[i] = (const float*)d_in[i];
    a.out = (float*)d_out; a.ws = (unsigned char*)d_ws;
#if MK_N_LAUNCHES == 1
    a.ph_lo = 0; a.ph_hi = 9;
    void* kargs[] = {&a};
    hipError_t e = hipLaunchCooperativeKernel((const void*)mk_fwd, dim3(grid), dim3(NWAVES * 64), kargs, LDS_BYTES, stream);
    if (e != hipSuccess) fprintf(stderr, "kernel_launch: cooperative launch failed: %s (grid %d)\n", hipGetErrorString(e), grid);
#else
    for (int p = 0; p < 9; ++p) { a.ph_lo = p; a.ph_hi = p + 1; hipLaunchKernelGGL(mk_fwd, dim3(grid), dim3(NWAVES * 64), LDS_BYTES, stream, a); }
#endif
}
```

```cpp
#include <hip/hip_runtime.h>
#include <hip/hip_cooperative_groups.h>
#include <hip/hip_bf16.h>
#include <cstdio>
#include <cstdint>
#include <cmath>
namespace cg = cooperative_groups;
#ifndef MK_N_LAUNCHES
#define MK_N_LAUNCHES 1
#endif
namespace pg8 {
#define PG8_LAS __attribute__((address_space(3)))
typedef unsigned short bf16_t;
typedef short bf16x8 __attribute__((ext_vector_type(8)));
typedef float f32x4 __attribute__((ext_vector_type(4)));
typedef unsigned u32x4 __attribute__((ext_vector_type(4)));
constexpr int BM = 256, BK = 64, HALF = 128, HTB = HALF * BK * 2  , STAGE_BYTES = 8 * HTB, NXCD = 8, WGM = 8;

__host__ __device__ __forceinline__ int lds_byte(int r, int c) { const int st = (r >> 4) * 2 + (c >> 5), rr = r & 15, cc = c & 31, ob = rr * 64 + cc * 2; return st * 1024 + (ob ^ (((ob >> 9) & 1) << 5)); }
__host__ __device__ __forceinline__ void stage_rc(int b, int& R, int& C) { const int st = b / 1024, sb = b % 1024, swz = sb ^ (((sb >> 9) & 1) << 5); R = (st >> 1) * 16 + swz / 64; C = (st & 1) * 32 + (swz % 64) / 2; }
__host__ __device__ __forceinline__ int perm32(int rho) { const int n = rho >> 4, i = rho & 15; return 8 * (i >> 2) + 4 * n + (i & 3); }

struct Unit { int pm, pn; };
struct Gemm { const bf16_t* A; const bf16_t* Bt; int M, N, K; };

struct StaticOrder {
    int nM, nN, nwg, G, c;
    __host__ __device__ void init(int M, int N, int G_, int c_) { nM = M / BM; nN = N / BM; nwg = nM * nN; G = G_; c = c_; }
    __host__ __device__ bool next(int i, Unit& u) const {
        const long L = (long)i * G + c; if (L >= nwg) return false;
        int wgid = (int)L; { const int q = nwg / NXCD, r = nwg % NXCD, xcd = wgid % NXCD, off = wgid / NXCD; wgid = (xcd < r ? xcd * (q + 1) : r * (q + 1) + (xcd - r) * q) + off; }
        const int nig = WGM * nN, gid = wgid / nig, fm = gid * WGM, gsz = (nM - fm) < WGM ? (nM - fm) : WGM;
        u.pm = fm + ((wgid % nig) % gsz); u.pn = (wgid % nig) / gsz; return true;
    }
    __device__ __forceinline__ void a_ready(const Unit&) const {}
    __device__ __forceinline__ void done(const Unit&) const {}
};

__device__ __forceinline__ unsigned cvt_pk_bf16(float lo, float hi) { unsigned r; asm volatile("v_cvt_pk_bf16_f32 %0, %1, %2" : "=v"(r) : "v"(lo), "v"(hi)); return r; }
typedef float f32x2 __attribute__((ext_vector_type(2)));
typedef unsigned u32x2 __attribute__((ext_vector_type(2)));
__device__ __forceinline__ float silu_f(float v) { return v * __builtin_amdgcn_rcpf(1.f + __builtin_amdgcn_exp2f(-1.4426950408889634f * v)); }
__device__ __forceinline__ float gelu_tanh_f(float v) { const float u = v * (2.302208198f + 0.1029432397f * v * v); return v * __builtin_amdgcn_rcpf(1.f + __builtin_amdgcn_exp2f(-u)); }
__device__ __forceinline__ float sigmoid_f(float v) { return 1.f / (1.f + __expf(-v)); }

struct EpiProj {
    static constexpr bool PERM = true, AFTER_DRAIN = false;
    bf16_t* O; float* vsum; float* vsq; unsigned char* kvimg;
    __device__ __forceinline__ void operator()(const f32x4 (&acc)[2][2][4][2], const Unit& u, int wr, int wc, int fr, int fq) const {
        const int seg = u.pn >> 3;
        const int row0 = u.pm * BM + wr * 64 + fr, col0 = u.pn * BM + wc * 32 + 8 * fq;
        float t1[2][4], t2[2][4];
#pragma unroll
        for (int ai = 0; ai < 2; ++ai)
#pragma unroll
            for (int m = 0; m < 4; ++m) { const int row = row0 + ai * HALF + m * 16; bf16_t* rowp = O + (size_t)row * 14336 + col0; float s1 = 0.f, s2 = 0.f;
#pragma unroll
                for (int bj = 0; bj < 2; ++bj) { f32x4 v0 = acc[ai][bj][m][0], v1 = acc[ai][bj][m][1];
                    if (seg == 3 || seg == 6) {
#pragma unroll
                        for (int e = 0; e < 4; ++e) { v0[e] = silu_f(v0[e]); v1[e] = silu_f(v1[e]); }
                    } else if (seg == 4 || seg == 5) {
#pragma unroll
                        for (int e = 0; e < 4; ++e) { v0[e] = gelu_tanh_f(v0[e]); v1[e] = gelu_tanh_f(v1[e]); }
                        if (seg == 5) {
#pragma unroll
                            for (int e = 0; e < 4; ++e) { s1 += v0[e] + v1[e]; s2 += v0[e] * v0[e] + v1[e] * v1[e]; } }
                    }
                    u32x4 w; w.x = cvt_pk_bf16(v0[0], v0[1]); w.y = cvt_pk_bf16(v0[2], v0[3]); w.z = cvt_pk_bf16(v1[0], v1[1]); w.w = cvt_pk_bf16(v1[2], v1[3]);
                    if (seg == 1 || seg == 2) {
                        const int bb = row >> 12, key = row & 4095, tt = key >> 6, k = key & 63, hh = u.pn & 7, c = wc * 32 + 8 * fq;
                        unsigned off;
                        if (seg == 1) off = (unsigned)(bj * 16384 + k * 256 + ((c * 2) ^ ((k & 7) << 4)));
                        else { const int kk = (k & ~0xC) | ((k & 4) << 1) | ((k & 8) >> 1); off = (unsigned)(32768 + bj * 16384 + ((kk >> 3) * 4 + (c >> 5)) * 512 + ((kk & 7) * 32 + (c & 31)) * 2); }
                        *(u32x4*)(kvimg + ((size_t)((bb * 8 + hh) * 64 + tt) << 16) + off) = w;
                    } else *(u32x4*)(rowp + bj * HALF) = w; }
                if (seg == 5 && vsum) { s1 += __shfl_xor(s1, 16); s1 += __shfl_xor(s1, 32); s2 += __shfl_xor(s2, 16); s2 += __shfl_xor(s2, 32); t1[ai][m] = s1; t2[ai][m] = s2; } }
        if (seg == 5 && vsum) {
#pragma unroll
            for (int ai = 0; ai < 2; ++ai) { const int r64 = u.pm * BM + wr * 64 + ai * HALF + fq * 16 + fr;
                const float a1 = fq == 0 ? t1[ai][0] : fq == 1 ? t1[ai][1] : fq == 2 ? t1[ai][2] : t1[ai][3], a2 = fq == 0 ? t2[ai][0] : fq == 1 ? t2[ai][1] : fq == 2 ? t2[ai][2] : t2[ai][3];
                atomicAdd(vsum + r64, a1); atomicAdd(vsq + r64, a2); } }
    }
};
template <bool WB> struct EpiRes {
    static constexpr bool PERM = false, AFTER_DRAIN = false;
    const float* base; float* out; bf16_t* ob; float* ss;
    __device__ __forceinline__ void operator()(const f32x4 (&acc)[2][2][4][2], const Unit& u, int wr, int wc, int fr, int fq) const {
        const int row0 = u.pm * BM + wr * 64 + fr, col0 = u.pn * BM + wc * 32 + 4 * fq;
        float ts[2][4];
#pragma unroll
        for (int ai = 0; ai < 2; ++ai)
#pragma unroll
            for (int m = 0; m < 4; ++m) { const int row = row0 + ai * HALF + m * 16; const size_t off = (size_t)row * 2048 + col0; float s = 0.f;
#pragma unroll
                for (int bj = 0; bj < 2; ++bj)
#pragma unroll
                    for (int n = 0; n < 2; ++n) { const size_t o2 = off + bj * HALF + n * 16; const f32x4 b = __builtin_nontemporal_load((const f32x4*)(base + o2)); const f32x4 o = b + acc[ai][bj][m][n];
                        *(f32x4*)(out + o2) = o; s += (o[0] * o[0] + o[1] * o[1]) + (o[2] * o[2] + o[3] * o[3]);
                        if (WB) { u32x2 w; w.x = cvt_pk_bf16(o[0], o[1]); w.y = cvt_pk_bf16(o[2], o[3]); *(u32x2*)(ob + o2) = w; } }
                s += __shfl_xor(s, 16); s += __shfl_xor(s, 32); ts[ai][m] = s; }
        if (ss) {
#pragma unroll
            for (int ai = 0; ai < 2; ++ai) { const float a = fq == 0 ? ts[ai][0] : fq == 1 ? ts[ai][1] : fq == 2 ? ts[ai][2] : ts[ai][3];
                atomicAdd(ss + u.pm * BM + wr * 64 + ai * HALF + fq * 16 + fr, a); } }
    }
};
struct EpiProj2 {
    static constexpr bool PERM = true, AFTER_DRAIN = false;
    bf16_t* O; const float* ss;
    __device__ __forceinline__ void operator()(const f32x4 (&acc)[2][2][4][2], const Unit& u, int wr, int wc, int fr, int fq) const {
        const int row0 = u.pm * BM + wr * 64 + fr, colt = u.pn * BM, col0 = colt + wc * 32 + 8 * fq;
#pragma unroll
        for (int ai = 0; ai < 2; ++ai)
#pragma unroll
            for (int m = 0; m < 4; ++m) { const int row = row0 + ai * HALF + m * 16; bf16_t* rowp = O + (size_t)row * 5376 + col0;
                const float rs = rsqrtf(ss[row] * (1.f / 2048.f) + 1e-6f);
#pragma unroll
                for (int bj = 0; bj < 2; ++bj) { f32x4 v0 = acc[ai][bj][m][0] * rs, v1 = acc[ai][bj][m][1] * rs;
                    if (colt + bj * HALF >= 2688) {
#pragma unroll
                        for (int e = 0; e < 4; ++e) { v0[e] = silu_f(v0[e]); v1[e] = silu_f(v1[e]); } }
                    u32x4 w; w.x = cvt_pk_bf16(v0[0], v0[1]); w.y = cvt_pk_bf16(v0[2], v0[3]); w.z = cvt_pk_bf16(v1[0], v1[1]); w.w = cvt_pk_bf16(v1[2], v1[3]);
                    *(u32x4*)(rowp + bj * HALF) = w; } }
    }
};
struct EpiFinal {
    static constexpr bool PERM = false, AFTER_DRAIN = true;
    const float* base; float* out; float* ss; unsigned* cnt; const float* g;
    __device__ __forceinline__ void fused(f32x4 (&acc)[2][2][4][2], const Unit& u, int wr, int wc, int fr, int fq, PG8_LAS unsigned char* lds, int wid, int lane) const {
        const int row0 = u.pm * BM + wr * 64 + fr, col0 = u.pn * BM + wc * 32 + 4 * fq;
        float ts[2][4];
#pragma unroll
        for (int ai = 0; ai < 2; ++ai)
#pragma unroll
            for (int m = 0; m < 4; ++m) { const int row = row0 + ai * HALF + m * 16; const size_t off = (size_t)row * 2048 + col0; float s = 0.f;
#pragma unroll
                for (int bj = 0; bj < 2; ++bj)
#pragma unroll
                    for (int n = 0; n < 2; ++n) { const f32x4 b = __builtin_nontemporal_load((const f32x4*)(base + off + bj * HALF + n * 16)); const f32x4 o = b + acc[ai][bj][m][n]; acc[ai][bj][m][n] = o;
                        s += (o[0] * o[0] + o[1] * o[1]) + (o[2] * o[2] + o[3] * o[3]); }
                s += __shfl_xor(s, 16); s += __shfl_xor(s, 32); ts[ai][m] = s;
                if (m & 1) asm volatile("" ::: "memory"); }
#pragma unroll
        for (int ai = 0; ai < 2; ++ai) { const float a = fq == 0 ? ts[ai][0] : fq == 1 ? ts[ai][1] : fq == 2 ? ts[ai][2] : ts[ai][3];
            __hip_atomic_fetch_add(ss + u.pm * BM + wr * 64 + ai * HALF + fq * 16 + fr, a, __ATOMIC_RELAXED, __HIP_MEMORY_SCOPE_AGENT); }
        asm volatile("s_waitcnt vmcnt(0)" ::: "memory");
        unsigned* c = cnt + 64 * u.pm;
        if (lane == 0) __hip_atomic_fetch_add(c, 1u, __ATOMIC_RELAXED, __HIP_MEMORY_SCOPE_AGENT);
        { unsigned sp = 0; while (__hip_atomic_load(c, __ATOMIC_RELAXED, __HIP_MEMORY_SCOPE_AGENT) < 64u) { __builtin_amdgcn_s_sleep(2); if (++sp > (1u << 22)) break; } }
        __builtin_amdgcn_fence(__ATOMIC_ACQUIRE, "agent");
#pragma unroll
        for (int ai = 0; ai < 2; ++ai)
#pragma unroll
            for (int m = 0; m < 4; ++m) { const int row = row0 + ai * HALF + m * 16; const size_t off = (size_t)row * 2048 + col0;
                const float rs = rsqrtf(__hip_atomic_load(ss + row, __ATOMIC_RELAXED, __HIP_MEMORY_SCOPE_AGENT) * (1.f / 2048.f) + 1e-6f);
#pragma unroll
                for (int bj = 0; bj < 2; ++bj)
#pragma unroll
                    for (int n = 0; n < 2; ++n) { const f32x4 gv = *(const f32x4*)(g + col0 + bj * HALF + n * 16); __builtin_nontemporal_store(acc[ai][bj][m][n] * rs * gv, (f32x4*)(out + off + bj * HALF + n * 16)); } }
    }
};
template <class Epi, class Sched, bool ALIGN_EPI = false, bool SP2 = false>
__device__ __forceinline__ void gemm_phase(PG8_LAS unsigned char* lds, const Gemm g, const Sched& S, const Epi& E) {
    int tid_ = threadIdx.x; asm volatile("" : "+v"(tid_)); const int tid = tid_, wid = __builtin_amdgcn_readfirstlane(tid >> 6), lane = tid & 63, wr = wid >> 2, wc = wid & 3, fr = lane & 15, fq = lane >> 4;
    const int K = g.K, nt = K / BK;
    unsigned voffA[2], voffB[2];
#pragma unroll
    for (int i = 0; i < 2; ++i) { int R, C; stage_rc(tid * 16 + i * 8192, R, C); const int Rb = Epi::PERM ? ((R & ~31) + perm32(R & 31)) : R;
        voffA[i] = (unsigned)(R * K + C) * 2u; voffB[i] = (unsigned)(Rb * K + C) * 2u; }
    const size_t kstep = (size_t)(BK * 2);
    const size_t hstep = (size_t)HALF * K * 2;
    const size_t tstep = 2 * hstep;
    const unsigned ldsw = (unsigned)wid * 1024u;
    const int aoff = lds_byte(wr * 64 + fr, fq * 8), boff = lds_byte(wc * 32 + fr, fq * 8);
#define PG8_SA(b, h) (((b) * 2 + (h)) * HTB)
#define PG8_SB(b, h) ((4 + (b) * 2 + (h)) * HTB)
#define PG8_STAGE(bufoff, gbase, voff) do { _Pragma("unroll") for (int _i = 0; _i < 2; ++_i) \
        __builtin_amdgcn_global_load_lds((const unsigned*)((const char*)(gbase) + (voff)[_i]), (PG8_LAS unsigned*)(lds + (bufoff) + ldsw + _i * 8192), 16, 0, 0); } while (0)
#define PG8_LDA(dst, b, h) do { _Pragma("unroll") for (int m = 0; m < 4; ++m) _Pragma("unroll") for (int k = 0; k < 2; ++k) dst[m][k] = *(const PG8_LAS bf16x8*)(lds + PG8_SA(b, h) + aoff + m * 2048 + k * 1024); } while (0)
#define PG8_LDB(dst, b, h) do { _Pragma("unroll") for (int n = 0; n < 2; ++n) _Pragma("unroll") for (int k = 0; k < 2; ++k) dst[n][k] = *(const PG8_LAS bf16x8*)(lds + PG8_SB(b, h) + boff + n * 2048 + k * 1024); } while (0)
#define PG8_MMA(ai, bj, At, Bt) do { __builtin_amdgcn_s_setprio(1); _Pragma("unroll") for (int m = 0; m < 4; ++m) _Pragma("unroll") for (int n = 0; n < 2; ++n) _Pragma("unroll") for (int k = 0; k < 2; ++k) \
        acc[ai][bj][m][n] = __builtin_amdgcn_mfma_f32_16x16x32_bf16(Bt[n][k], At[m][k], acc[ai][bj][m][n], 0, 0, 0); __builtin_amdgcn_s_setprio(0); } while (0)
#define PG8_WAIT_V(n) asm volatile("s_waitcnt vmcnt(" #n ")" ::: "memory")
#define PG8_WAIT_L(n) asm volatile("s_waitcnt lgkmcnt(" #n ")" ::: "memory")
#define PG8_BAR __builtin_amdgcn_s_barrier()
#define PG8_SCHED __builtin_amdgcn_sched_barrier(0)
    Unit cur, nxt; int ui = 0;
    if (!S.next(0, cur)) return;
    f32x4 acc[2][2][4][2];
#pragma unroll
    for (int a = 0; a < 2; ++a)
#pragma unroll
        for (int b = 0; b < 2; ++b)
#pragma unroll
            for (int m = 0; m < 4; ++m)
#pragma unroll
                for (int n = 0; n < 2; ++n) acc[a][b][m][n] = (f32x4){0.f, 0.f, 0.f, 0.f};
    bf16x8 At[4][2], B0[2][2], B1[2][2];
    const char* cA = (const char*)g.A + (size_t)cur.pm * tstep; const char* cB = (const char*)g.Bt + (size_t)cur.pn * tstep;
    S.a_ready(cur);
    if constexpr (SP2) {
        PG8_STAGE(PG8_SB(0, 0), cB, voffB); PG8_STAGE(PG8_SB(0, 1), cB + hstep, voffB); PG8_STAGE(PG8_SA(0, 0), cA, voffA); PG8_STAGE(PG8_SA(0, 1), cA + hstep, voffA);
        if (wr == 1) PG8_BAR;
        PG8_WAIT_V(2); PG8_BAR;
        PG8_STAGE(PG8_SB(1, 0), cB + kstep, voffB); PG8_STAGE(PG8_SA(1, 0), cA + kstep, voffA); PG8_STAGE(PG8_SB(1, 1), cB + hstep + kstep, voffB);
        PG8_WAIT_V(6); PG8_BAR;
    } else {
        PG8_STAGE(PG8_SB(0, 0), cB, voffB); PG8_STAGE(PG8_SA(0, 0), cA, voffA); PG8_STAGE(PG8_SB(0, 1), cB + hstep, voffB); PG8_STAGE(PG8_SA(0, 1), cA + hstep, voffA);
        if (wr == 1) PG8_BAR;
        PG8_WAIT_V(4); PG8_BAR;
        PG8_STAGE(PG8_SB(1, 0), cB + kstep, voffB); PG8_STAGE(PG8_SA(1, 0), cA + kstep, voffA); PG8_STAGE(PG8_SB(1, 1), cB + hstep + kstep, voffB);
        PG8_WAIT_V(6); PG8_BAR;
    }
    for (;;) {
        const bool has_next = S.next(ui + 1, nxt);
        const char* nA = has_next ? (const char*)g.A + (size_t)nxt.pm * tstep : cA; const char* nB = has_next ? (const char*)g.Bt + (size_t)nxt.pn * tstep : cB;
        for (int t = 0; t < nt; t += 2) {
            const bool last = (t == nt - 2);
            const char* a1 = cA + (size_t)(t + 1) * kstep;
            const char* a2 = last ? nA : cA + (size_t)(t + 2) * kstep; const char* b2 = last ? nB : cB + (size_t)(t + 2) * kstep;
            const char* a3 = a2 + kstep; const char* b3 = b2 + kstep;
            if (last && has_next) S.a_ready(nxt);
            if constexpr (SP2) {
            PG8_LDB(B0, 0, 0); PG8_LDB(B1, 0, 1); PG8_SCHED; PG8_LDA(At, 0, 0); PG8_STAGE(PG8_SA(1, 1), a1 + hstep, voffA);
            PG8_WAIT_V(8); PG8_WAIT_L(0); PG8_BAR; PG8_MMA(0, 0, At, B0); PG8_MMA(0, 1, At, B1); PG8_BAR; PG8_SCHED;
            PG8_LDA(At, 0, 1); PG8_STAGE(PG8_SB(0, 0), b2, voffB); PG8_STAGE(PG8_SB(0, 1), b2 + hstep, voffB); PG8_STAGE(PG8_SA(0, 0), a2, voffA);
            PG8_WAIT_V(8); PG8_WAIT_L(0); PG8_BAR; PG8_MMA(1, 0, At, B0); PG8_MMA(1, 1, At, B1); PG8_BAR; PG8_SCHED;
            PG8_LDB(B0, 1, 0); PG8_LDB(B1, 1, 1); PG8_SCHED; PG8_LDA(At, 1, 0); PG8_STAGE(PG8_SA(0, 1), a2 + hstep, voffA);
            PG8_WAIT_V(8); PG8_WAIT_L(0); PG8_BAR; PG8_MMA(0, 0, At, B0); PG8_MMA(0, 1, At, B1); PG8_BAR; PG8_SCHED;
            PG8_LDA(At, 1, 1); PG8_STAGE(PG8_SB(1, 0), b3, voffB); PG8_STAGE(PG8_SB(1, 1), b3 + hstep, voffB); PG8_STAGE(PG8_SA(1, 0), a3, voffA);
            PG8_WAIT_V(8); PG8_WAIT_L(0); PG8_BAR; PG8_MMA(1, 0, At, B0); PG8_MMA(1, 1, At, B1); PG8_BAR; PG8_SCHED;
            } else {
            PG8_LDB(B0, 0, 0); PG8_SCHED; PG8_LDA(At, 0, 0); PG8_STAGE(PG8_SA(1, 1), a1 + hstep, voffA);
            PG8_WAIT_L(8); PG8_BAR; PG8_WAIT_L(0); PG8_MMA(0, 0, At, B0); PG8_BAR; PG8_SCHED;
            PG8_LDB(B1, 0, 1); PG8_STAGE(PG8_SB(0, 0), b2, voffB);
            PG8_BAR; PG8_WAIT_L(0); PG8_MMA(0, 1, At, B1); PG8_BAR;
            PG8_LDA(At, 0, 1); PG8_STAGE(PG8_SA(0, 0), a2, voffA);
            PG8_BAR; PG8_WAIT_L(0); PG8_MMA(1, 0, At, B0); PG8_BAR; PG8_SCHED;
            PG8_STAGE(PG8_SB(0, 1), b2 + hstep, voffB);
            PG8_WAIT_V(6); PG8_BAR; PG8_MMA(1, 1, At, B1); PG8_BAR;
            PG8_LDB(B0, 1, 0); PG8_SCHED; PG8_LDA(At, 1, 0); PG8_STAGE(PG8_SA(0, 1), a2 + hstep, voffA);
            PG8_WAIT_L(8); PG8_BAR; PG8_WAIT_L(0); PG8_MMA(0, 0, At, B0); PG8_BAR; PG8_SCHED;
            PG8_LDB(B1, 1, 1); PG8_STAGE(PG8_SB(1, 0), b3, voffB);
            PG8_BAR; PG8_WAIT_L(0); PG8_MMA(0, 1, At, B1); PG8_BAR;
            PG8_LDA(At, 1, 1); PG8_STAGE(PG8_SA(1, 0), a3, voffA);
            PG8_BAR; PG8_WAIT_L(0); PG8_MMA(1, 0, At, B0); PG8_BAR; PG8_SCHED;
            PG8_STAGE(PG8_SB(1, 1), b3 + hstep, voffB);
            PG8_WAIT_V(6); PG8_BAR; PG8_MMA(1, 1, At, B1); PG8_BAR;
            }
        }
        if constexpr (ALIGN_EPI) { if (wr == 0) PG8_BAR; }
        if constexpr (!Epi::AFTER_DRAIN) { E(acc, cur, wr, wc, fr, fq); S.done(cur); }
        if (!has_next) break;
#pragma unroll
        for (int a = 0; a < 2; ++a)
#pragma unroll
            for (int b = 0; b < 2; ++b)
#pragma unroll
                for (int m = 0; m < 4; ++m)
#pragma unroll
                    for (int n = 0; n < 2; ++n) acc[a][b][m][n] = (f32x4){0.f, 0.f, 0.f, 0.f};
        cur = nxt; cA = nA; cB = nB; ++ui;
        if constexpr (ALIGN_EPI) { if (wr == 1) PG8_BAR; }
    }
    PG8_WAIT_V(0);
    if constexpr (!ALIGN_EPI) { if (wr == 0) PG8_BAR; }
    PG8_BAR;
    if constexpr (Epi::AFTER_DRAIN) { E.fused(acc, cur, wr, wc, fr, fq, lds, wid, lane); S.done(cur); }
#undef PG8_SA
#undef PG8_SB
#undef PG8_STAGE
#undef PG8_LDA
#undef PG8_LDB
#undef PG8_MMA
#undef PG8_WAIT_V
#undef PG8_WAIT_L
#undef PG8_BAR
#undef PG8_SCHED
}
}

#ifndef PG8_SP2
#define PG8_SP2 true
#endif
namespace att {
using bf16 = __hip_bfloat16;
using bf16x8 = __attribute__((ext_vector_type(8))) short;
using s16x4  = __attribute__((ext_vector_type(4))) short;
using f32x16 = __attribute__((ext_vector_type(16))) float;
using f32x4  = __attribute__((ext_vector_type(4))) float;
using u32x4  = __attribute__((ext_vector_type(4))) unsigned;
using u32x2  = __attribute__((ext_vector_type(2))) unsigned;
constexpr float SCALE = 0.088388347648318440f;
constexpr float THR = 8.f;
constexpr int LDP = 14336;
constexpr int SUB = 16384, BUFB = 4 * SUB, ATT_WS = 2 * BUFB;
#define KSWZ(row, colB) ((row) * 256 + ((colB) ^ (((row) & 7) << 4)))
#define SBAR() __builtin_amdgcn_sched_barrier(0)
__device__ __forceinline__ int crow(int r, int hi) { return (r & 3) + 8 * (r >> 2) + 4 * hi; }
__device__ __forceinline__ unsigned cvtpk(float lo, float hi) {
  unsigned r; asm volatile("v_cvt_pk_bf16_f32 %0, %1, %2" : "=v"(r) : "v"(lo), "v"(hi)); return r;
}
__device__ __forceinline__ void partialSM(f32x16& p0, f32x16& p1, float& m_reg, float& mn, float& alpha) {
  constexpr float C = SCALE * 1.4426950408889634f;
  float pmax = p0[0]; for (int r = 1; r < 16; ++r) pmax = fmaxf(pmax, p0[r]); for (int r = 0; r < 16; ++r) pmax = fmaxf(pmax, p1[r]);
  { auto rr = __builtin_amdgcn_permlane32_swap(__float_as_uint(pmax), __float_as_uint(pmax), false, false);
    pmax = fmaxf(__uint_as_float(rr[0]), __uint_as_float(rr[1])); }
  if (__builtin_expect(__all(pmax - m_reg <= THR / SCALE), 1)) { mn = m_reg; alpha = 1.f; }
  else { mn = fmaxf(m_reg, pmax); alpha = __builtin_amdgcn_exp2f((m_reg - mn) * C); m_reg = mn; }
  float mnC = -mn * C;
  for (int r = 0; r < 16; ++r) p0[r] = fmaf(p0[r], C, mnC); for (int r = 0; r < 16; ++r) p1[r] = fmaf(p1[r], C, mnC);
  for (int r = 0; r < 16; ++r) p0[r] = __builtin_amdgcn_exp2f(p0[r]);
}
__device__ __forceinline__ void finishSM(f32x16& p0, f32x16& p1, float alpha, float& l_reg, bf16x8& pa0, bf16x8& pa1, bf16x8& pa2, bf16x8& pa3) {
  for (int r = 0; r < 16; ++r) p1[r] = __builtin_amdgcn_exp2f(p1[r]);
  float ps = 0; for (int r = 0; r < 16; ++r) ps += p0[r]; for (int r = 0; r < 16; ++r) ps += p1[r];
  { auto rr = __builtin_amdgcn_permlane32_swap(__float_as_uint(ps), __float_as_uint(ps), false, false);
    ps = __uint_as_float(rr[0]) + __uint_as_float(rr[1]); }
  l_reg = l_reg * alpha + ps;
#define PK4(P, BASE, OUT) do { unsigned a0 = cvtpk(P[BASE + 0], P[BASE + 1]), a1 = cvtpk(P[BASE + 2], P[BASE + 3]);   \
    unsigned b0 = cvtpk(P[BASE + 4], P[BASE + 5]), b1 = cvtpk(P[BASE + 6], P[BASE + 7]);                              \
    auto r0 = __builtin_amdgcn_permlane32_swap(a0, b0, false, false); auto r1 = __builtin_amdgcn_permlane32_swap(a1, b1, false, false); \
    u32x4 w = {r0[0], r1[0], r0[1], r1[1]}; OUT = *reinterpret_cast<bf16x8*>(&w); } while (0)
  PK4(p0, 0, pa0); PK4(p0, 8, pa1); PK4(p1, 0, pa2); PK4(p1, 8, pa3);
#undef PK4
}
__device__ __forceinline__ void qkt(f32x16& p0, f32x16& p1, const bf16* Ks, const bf16x8* qr, int r32, int hi) {
  p0 = f32x16{}; p1 = f32x16{};
  for (int d0 = 0; d0 < 8; ++d0) { int cb = (d0 * 16 + hi * 8) * 2;
    bf16x8 b0 = *reinterpret_cast<const bf16x8*>((const char*)Ks + KSWZ(r32, cb));
    bf16x8 b1 = *reinterpret_cast<const bf16x8*>((const char*)Ks + KSWZ(32 + r32, cb));
    p0 = __builtin_amdgcn_mfma_f32_32x32x16_bf16(b0, qr[d0], p0, 0, 0, 0);
    p1 = __builtin_amdgcn_mfma_f32_32x32x16_bf16(b1, qr[d0], p1, 0, 0, 0); }
}
__device__ __forceinline__ int v_st(int k, int c) { const int kk = (k & ~0xC) | ((k & 4) << 1) | ((k & 8) >> 1); return ((kk >> 3) * 4 + (c >> 5)) * 512 + ((kk & 7) * 32 + (c & 31)) * 2; }
__device__ __forceinline__ int v_rd_base(int lane) { return ((lane & 3) << 3) | (((lane >> 2) & 3) << 6) | (((lane >> 4) & 1) << 5) | (((lane >> 5) & 1) << 8); }
constexpr int v_rd_off(int d0, int ks, int half) { return d0 * 512 + ks * 4096 + half * 2048; }
template <int OFF> __device__ __forceinline__ s16x4 tr_read(int vb) {
  s16x4 r; asm volatile("ds_read_b64_tr_b16 %0, %1 offset:%2" : "=&v"(r) : "v"(vb), "i"(OFF) : "memory"); return r;
}
template <int D0> __device__ __forceinline__ void pv_one(f32x16& od, int vb, bf16x8 pa0, bf16x8 pa1, bf16x8 pa2, bf16x8 pa3) {
  const s16x4 l0 = tr_read<v_rd_off(D0, 0, 0)>(vb), h0 = tr_read<v_rd_off(D0, 0, 1)>(vb), l1 = tr_read<v_rd_off(D0, 1, 0)>(vb), h1 = tr_read<v_rd_off(D0, 1, 1)>(vb);
  const s16x4 l2 = tr_read<v_rd_off(D0, 2, 0)>(vb), h2 = tr_read<v_rd_off(D0, 2, 1)>(vb), l3 = tr_read<v_rd_off(D0, 3, 0)>(vb), h3 = tr_read<v_rd_off(D0, 3, 1)>(vb);
  asm volatile("s_waitcnt lgkmcnt(0)" ::: "memory"); SBAR();
#define PK(L, H) (bf16x8){L[0], L[1], L[2], L[3], H[0], H[1], H[2], H[3]}
  od = __builtin_amdgcn_mfma_f32_32x32x16_bf16(pa0, PK(l0, h0), od, 0, 0, 0);
  od = __builtin_amdgcn_mfma_f32_32x32x16_bf16(pa1, PK(l1, h1), od, 0, 0, 0);
  od = __builtin_amdgcn_mfma_f32_32x32x16_bf16(pa2, PK(l2, h2), od, 0, 0, 0);
  od = __builtin_amdgcn_mfma_f32_32x32x16_bf16(pa3, PK(l3, h3), od, 0, 0, 0);
#undef PK
}
__device__ __forceinline__ void pv_d0(f32x16* o, int vb, bf16x8 pa0, bf16x8 pa1, bf16x8 pa2, bf16x8 pa3) {
  pv_one<0>(o[0], vb, pa0, pa1, pa2, pa3); pv_one<1>(o[1], vb, pa0, pa1, pa2, pa3); pv_one<2>(o[2], vb, pa0, pa1, pa2, pa3); pv_one<3>(o[3], vb, pa0, pa1, pa2, pa3);
}
__device__ __forceinline__ float bf2f(unsigned short s) { return __uint_as_float((unsigned)s << 16); }
__device__ __forceinline__ float wave_sum(float v) {
#pragma unroll
  for (int o = 1; o < 64; o <<= 1) v += __shfl_xor(v, o);
  return v;
}
__device__ __forceinline__ void attn_unit(int b, int h, int qc, const bf16* __restrict__ proj, bf16* __restrict__ ymix, float lam, const float* __restrict__ hnorm, char* lds) {
  int tid_ = threadIdx.x; asm volatile("" : "+v"(tid_)); const int tid = tid_, wid = __builtin_amdgcn_readfirstlane(tid >> 6), lane = tid & 63, r32 = lane & 31, hi = lane >> 5;
  asm volatile("" : "+s"(b), "+s"(h), "+s"(proj), "+s"(ymix), "+s"(hnorm));
  proj = (const bf16*)(const __attribute__((address_space(1))) bf16*)(uintptr_t)proj; ymix = (bf16*)(__attribute__((address_space(1))) bf16*)(uintptr_t)ymix;
  hnorm = (const float*)(const __attribute__((address_space(1))) float*)(uintptr_t)hnorm;
  const int rg = wid & 1, map = (wid >> 1) & 1, vh = wid >> 2;
  float* ws = (float*)(lds + ATT_WS) + wid * 64; float* li_l = ws; float* al_l = ws + 32;
  const long rowbase = (long)b * 4096;
  const bf16* Kg = proj + rowbase * LDP + 2048 + h * 256;
  const bf16* Vg = proj + rowbase * LDP + 4096 + h * 256;
  const bf16* Qw = proj + (rowbase + qc * 64 + rg * 32 + r32) * LDP + h * 256 + map * 128 + hi * 8;
  float m_reg = -1e30f, l_reg = 0; f32x16 o[4] = {}; bf16x8 qr[8];
#pragma unroll
  for (int d0 = 0; d0 < 8; ++d0) qr[d0] = *reinterpret_cast<const bf16x8*>(Qw + d0 * 16);
  const int sr = tid >> 4, sc = (tid & 15) * 8, vst0 = v_st(sr, sc), vst1 = v_st(32 + sr, sc), kst0 = KSWZ(sr, sc * 2), kst1 = KSWZ(32 + sr, sc * 2);
  const int vb0 = (int)(uintptr_t)lds + 2 * SUB + vh * SUB + v_rd_base(lane);
  const bf16* Kt0 = (const bf16*)(lds + map * SUB); const bf16* Kt1 = (const bf16*)(lds + BUFB + map * SUB);
  bf16x8 s0, s1, s2, s3;
#define SLOADK(k0) do { const bf16* kp = Kg + (long)((k0) + sr) * LDP + sc; \
    s0 = *(const bf16x8*)kp; s1 = *(const bf16x8*)(kp + 32L * LDP); s2 = *(const bf16x8*)(kp + 128); s3 = *(const bf16x8*)(kp + 32L * LDP + 128); } while (0)
#define SLOADV(k0) do { const bf16* vp = Vg + (long)((k0) + sr) * LDP + sc; \
    s0 = *(const bf16x8*)vp; s1 = *(const bf16x8*)(vp + 32L * LDP); s2 = *(const bf16x8*)(vp + 128); s3 = *(const bf16x8*)(vp + 32L * LDP + 128); } while (0)
#define SWRITEK(bf) do { char* bb = lds + (bf) * BUFB; *(bf16x8*)(bb + kst0) = s0; *(bf16x8*)(bb + kst1) = s1; *(bf16x8*)(bb + SUB + kst0) = s2; *(bf16x8*)(bb + SUB + kst1) = s3; } while (0)
#define SWRITEV(bf) do { char* bb = lds + (bf) * BUFB + 2 * SUB; *(bf16x8*)(bb + vst0) = s0; *(bf16x8*)(bb + vst1) = s1; *(bf16x8*)(bb + SUB + vst0) = s2; *(bf16x8*)(bb + SUB + vst1) = s3; } while (0)
#define SWAIT() asm volatile("s_waitcnt vmcnt(0)" ::: "memory")
#define RESC(a) do { if (__any((a) < 1.f)) { if (hi == 0) al_l[r32] = (a); asm volatile("s_waitcnt lgkmcnt(0)" ::: "memory"); \
    for (int d = 0; d < 4; ++d) for (int r = 0; r < 16; ++r) o[d][r] *= al_l[crow(r, hi)]; } } while (0)
  f32x16 pA0, pA1, pB0, pB1; float mnA, mnB, alA, alB; bf16x8 pa0, pa1, pa2, pa3; const int NT = qc + 1;
  SLOADK(0); SWAIT(); SWRITEK(0); SLOADV(0); SWAIT(); SWRITEV(0); __syncthreads();
  if (NT > 1) SLOADK(64);
  qkt(pA0, pA1, Kt0, qr, r32, hi); partialSM(pA0, pA1, m_reg, mnA, alA);
  if (NT > 1) { SWAIT(); SWRITEK(1); SLOADV(64); SWAIT(); SWRITEV(1); }
  __syncthreads();
  int j = 1;
  for (; j + 1 < NT; j += 2) {
    SLOADK((j + 1) * 64);
    SBAR(); qkt(pB0, pB1, Kt1, qr, r32, hi);
    finishSM(pA0, pA1, alA, l_reg, pa0, pa1, pa2, pa3); SBAR();
    SWAIT(); SWRITEK(0); SLOADV((j + 1) * 64); SBAR();
    pv_d0(o, vb0, pa0, pa1, pa2, pa3); partialSM(pB0, pB1, m_reg, mnB, alB);
    __syncthreads(); SWAIT(); SWRITEV(0);
    RESC(alB); __syncthreads();
    const bool more = (j + 2 < NT);
    if (more) SLOADK((j + 2) * 64);
    SBAR(); qkt(pA0, pA1, Kt0, qr, r32, hi);
    finishSM(pB0, pB1, alB, l_reg, pa0, pa1, pa2, pa3); SBAR();
    if (more) { SWAIT(); SWRITEK(1); SLOADV((j + 2) * 64); } SBAR();
    pv_d0(o, vb0 + BUFB, pa0, pa1, pa2, pa3); partialSM(pA0, pA1, m_reg, mnA, alA);
    __syncthreads(); if (more) { SWAIT(); SWRITEV(1); }
    RESC(alA); __syncthreads();
  }
  if (j < NT) {
    SBAR(); qkt(pB0, pB1, Kt1, qr, r32, hi);
    finishSM(pA0, pA1, alA, l_reg, pa0, pa1, pa2, pa3); SBAR();
    pv_d0(o, vb0, pa0, pa1, pa2, pa3); partialSM(pB0, pB1, m_reg, mnB, alB);
    __syncthreads(); RESC(alB);
    finishSM(pB0, pB1, alB, l_reg, pa0, pa1, pa2, pa3); SBAR();
    pv_d0(o, vb0 + BUFB, pa0, pa1, pa2, pa3);
  } else {
    finishSM(pA0, pA1, alA, l_reg, pa0, pa1, pa2, pa3); SBAR();
    pv_d0(o, vb0, pa0, pa1, pa2, pa3);
  }
  if (hi == 0) li_l[r32] = l_reg;
  __syncthreads();
  { float* Ob = (float*)lds + wid * 4096;
#pragma unroll
    for (int r = 0; r < 16; ++r) { const int orow = crow(r, hi);
#pragma unroll
      for (int d0 = 0; d0 < 4; ++d0) Ob[orow * 128 + d0 * 32 + r32] = o[d0][r]; } }
  __syncthreads();
  const float* lall = (const float*)(lds + ATT_WS);
#pragma unroll 1
  for (int rr = 0; rr < 8; ++rr) {
    const int row = wid * 8 + rr, rg2 = row >> 5, r5 = row & 31, c = lane * 4, vh2 = c >> 7, cc = c & 127, w1 = rg2 + 4 * vh2;
    const float* O1 = (const float*)lds + w1 * 4096 + r5 * 128 + cc;
    const float il1 = 1.f / lall[w1 * 64 + r5], il2 = lam / lall[(w1 + 2) * 64 + r5];
    const f32x4 a = *(const f32x4*)O1 * il1, b2 = *(const f32x4*)(O1 + 2 * 4096) * il2;
    const f32x4 d = a - b2;
    const float ssq = wave_sum((d[0] * d[0] + d[1] * d[1]) + (d[2] * d[2] + d[3] * d[3]));
    const float rstd = rsqrtf(ssq * (1.f / 256.f) + 1e-6f) * 0.8f;
    const f32x4 g = *(const f32x4*)(hnorm + h * 256 + c);
    const long grow = rowbase + qc * 64 + row;
    const u32x2 zz = *(const u32x2*)(proj + grow * LDP + 6144 + h * 256 + c);
    const float z0 = __uint_as_float(zz.x << 16), z1 = __uint_as_float(zz.x & 0xffff0000u), z2 = __uint_as_float(zz.y << 16), z3 = __uint_as_float(zz.y & 0xffff0000u);
    u32x2 w; w.x = cvtpk(d[0] * rstd * g[0] * z0, d[1] * rstd * g[1] * z1); w.y = cvtpk(d[2] * rstd * g[2] * z2, d[3] * rstd * g[3] * z3);
    *(u32x2*)(ymix + grow * 4096 + h * 256 + c) = w;
  }
  __syncthreads();
#undef SLOADK
#undef SLOADV
#undef SWRITEK
#undef SWRITEV
#undef SWAIT
#undef RESC
}
template <int D0> __device__ __forceinline__ void pv_pair(f32x16& oa, f32x16& ob, int vb, bf16x8 pa0, bf16x8 pa1) {
  const s16x4 l0 = tr_read<v_rd_off(D0, 0, 0)>(vb), h0 = tr_read<v_rd_off(D0, 0, 1)>(vb), l1 = tr_read<v_rd_off(D0, 1, 0)>(vb), h1 = tr_read<v_rd_off(D0, 1, 1)>(vb);
  const s16x4 l2 = tr_read<v_rd_off(D0 + 1, 0, 0)>(vb), h2 = tr_read<v_rd_off(D0 + 1, 0, 1)>(vb), l3 = tr_read<v_rd_off(D0 + 1, 1, 0)>(vb), h3 = tr_read<v_rd_off(D0 + 1, 1, 1)>(vb);
  asm volatile("s_waitcnt lgkmcnt(0)" ::: "memory"); SBAR();
#define PK(L, H) (bf16x8){L[0], L[1], L[2], L[3], H[0], H[1], H[2], H[3]}
  oa = __builtin_amdgcn_mfma_f32_32x32x16_bf16(pa0, PK(l0, h0), oa, 0, 0, 0);
  ob = __builtin_amdgcn_mfma_f32_32x32x16_bf16(pa0, PK(l2, h2), ob, 0, 0, 0);
  oa = __builtin_amdgcn_mfma_f32_32x32x16_bf16(pa1, PK(l1, h1), oa, 0, 0, 0);
  ob = __builtin_amdgcn_mfma_f32_32x32x16_bf16(pa1, PK(l3, h3), ob, 0, 0, 0);
#undef PK
}
__device__ __forceinline__ void attn_unit2(int b, int h, int qc, bool rev, const unsigned char* kvimg, const bf16* __restrict__ proj, bf16* __restrict__ ymix, float lam, const float* __restrict__ hnorm, char* lds) {
  int tid_ = threadIdx.x; asm volatile("" : "+v"(tid_)); const int tid = tid_, wid = __builtin_amdgcn_readfirstlane(tid >> 6), lane = tid & 63, r32 = lane & 31, hi = lane >> 5;
  asm volatile("" : "+s"(b), "+s"(h), "+s"(proj), "+s"(ymix), "+s"(hnorm));
  proj = (const bf16*)(const __attribute__((address_space(1))) bf16*)(uintptr_t)proj; ymix = (bf16*)(__attribute__((address_space(1))) bf16*)(uintptr_t)ymix;
  hnorm = (const float*)(const __attribute__((address_space(1))) float*)(uintptr_t)hnorm;
  const int rg = wid & 1, map = (wid >> 1) & 1, kh = wid >> 2;
  float* ws = (float*)(lds + ATT_WS) + wid * 64; float* li_l = ws; float* al_l = ws + 32;
  const long rowbase = (long)b * 4096;
  const bf16* Qw = proj + (rowbase + qc * 64 + rg * 32 + r32) * LDP + h * 256 + map * 128 + hi * 8;
  bf16x8 qr[8];
#pragma unroll
  for (int d0 = 0; d0 < 8; ++d0) qr[d0] = *reinterpret_cast<const bf16x8*>(Qw + d0 * 16);
  __attribute__((address_space(3))) char* lds3 = (__attribute__((address_space(3))) char*)(unsigned)(uintptr_t)lds;
  asm volatile("" : "+s"(kvimg));
  const __attribute__((address_space(1))) char* imgu = (const __attribute__((address_space(1))) char*)(uintptr_t)kvimg + ((size_t)((b * 8 + h) * 64) << 16) + (wid >> 2) * SUB + (wid & 3) * 4096;
  const unsigned voff = (unsigned)lane * 16u;
  typedef __attribute__((address_space(3))) unsigned las_u32; typedef __attribute__((address_space(1))) const unsigned gas_u32;
#define DMAK_(t_, bf) do { gas_u32* kb_ = (gas_u32*)(imgu + ((size_t)(t_) << 16) + voff); las_u32* ldk_ = (las_u32*)(lds3 + (bf) * BUFB + (wid >> 2) * SUB + (wid & 3) * 4096); \
    __builtin_amdgcn_global_load_lds(kb_, ldk_, 16, 0, 0); __builtin_amdgcn_global_load_lds(kb_, ldk_, 16, 1024, 0); __builtin_amdgcn_global_load_lds(kb_, ldk_, 16, 2048, 0); __builtin_amdgcn_global_load_lds(kb_, ldk_, 16, 3072, 0); } while (0)
#define DMAV_(t_, bf) do { gas_u32* vb_ = (gas_u32*)(imgu + ((size_t)(t_) << 16) + 2 * SUB + voff); las_u32* ldv_ = (las_u32*)(lds3 + (bf) * BUFB + 2 * SUB + (wid >> 2) * SUB + (wid & 3) * 4096); \
    __builtin_amdgcn_global_load_lds(vb_, ldv_, 16, 0, 0); __builtin_amdgcn_global_load_lds(vb_, ldv_, 16, 1024, 0); __builtin_amdgcn_global_load_lds(vb_, ldv_, 16, 2048, 0); __builtin_amdgcn_global_load_lds(vb_, ldv_, 16, 3072, 0); } while (0)
#define DMAKV(t_, bf) do { DMAK_(t_, bf); DMAV_(t_, bf); } while (0)
  const int krow = 32 * kh + r32;
  const int vbk = (int)(uintptr_t)lds + 2 * SUB + kh * 8192 + v_rd_base(lane);
  float m_reg = -1e30f, l_reg = 0.f; f32x16 o[8] = {};
  constexpr float C = SCALE * 1.4426950408889634f;
  const int NT = qc + 1;
  DMAKV((rev ? NT - 1 : 0), 0); __syncthreads();
  for (int j = 0; j < NT; ++j) {
    const int bo = (j & 1) * BUFB;
    const int kn = (rev ? NT - 2 - j : j + 1);
    if (j + 1 < NT) DMAV_(kn, (j + 1) & 1);
    f32x16 p = {}; const char* Kb = lds + bo + map * SUB;
    { bf16x8 kf[8];
#pragma unroll
      for (int d0 = 0; d0 < 4; ++d0) kf[d0] = *reinterpret_cast<const bf16x8*>(Kb + KSWZ(krow, (d0 * 16 + hi * 8) * 2));
      SBAR();
#pragma unroll
      for (int d0 = 4; d0 < 8; ++d0) kf[d0] = *reinterpret_cast<const bf16x8*>(Kb + KSWZ(krow, (d0 * 16 + hi * 8) * 2));
#pragma unroll
      for (int d0 = 0; d0 < 8; ++d0) p = __builtin_amdgcn_mfma_f32_32x32x16_bf16(kf[d0], qr[d0], p, 0, 0, 0); }
    SBAR();
    if (j + 1 < NT) DMAK_(kn, (j + 1) & 1);
    SBAR();
    float pmax = p[0];
#pragma unroll
    for (int r = 1; r < 16; ++r) pmax = fmaxf(pmax, p[r]);
    { auto rr = __builtin_amdgcn_permlane32_swap(__float_as_uint(pmax), __float_as_uint(pmax), false, false); pmax = fmaxf(__uint_as_float(rr[0]), __uint_as_float(rr[1])); }
    float mn, alpha;
    if (__builtin_expect(__all(pmax - m_reg <= THR / SCALE), 1)) { mn = m_reg; alpha = 1.f; }
    else { mn = fmaxf(m_reg, pmax); alpha = __builtin_amdgcn_exp2f((m_reg - mn) * C); m_reg = mn; }
    const float mnC = -mn * C; float ps = 0.f;
#pragma unroll
    for (int r = 0; r < 16; ++r) { p[r] = __builtin_amdgcn_exp2f(fmaf(p[r], C, mnC)); ps += p[r]; }
    { auto rr = __builtin_amdgcn_permlane32_swap(__float_as_uint(ps), __float_as_uint(ps), false, false); ps = __uint_as_float(rr[0]) + __uint_as_float(rr[1]); }
    l_reg = l_reg * alpha + ps;
    if (__any(alpha < 1.f)) { if (hi == 0) al_l[r32] = alpha; asm volatile("s_waitcnt lgkmcnt(0)" ::: "memory");
#pragma unroll
      for (int d = 0; d < 8; ++d)
#pragma unroll
        for (int r = 0; r < 16; ++r) o[d][r] *= al_l[crow(r, hi)]; }
    bf16x8 pa0, pa1;
#define PK4(P, BASE, OUT) do { unsigned a0 = cvtpk(P[BASE + 0], P[BASE + 1]), a1 = cvtpk(P[BASE + 2], P[BASE + 3]);   \
    unsigned b0 = cvtpk(P[BASE + 4], P[BASE + 5]), b1 = cvtpk(P[BASE + 6], P[BASE + 7]);                              \
    auto r0 = __builtin_amdgcn_permlane32_swap(a0, b0, false, false); auto r1 = __builtin_amdgcn_permlane32_swap(a1, b1, false, false); \
    u32x4 w = {r0[0], r1[0], r0[1], r1[1]}; OUT = *reinterpret_cast<bf16x8*>(&w); } while (0)
    PK4(p, 0, pa0); PK4(p, 8, pa1);
#undef PK4
    SBAR();
    const int vb = vbk + bo;
    {
#define PVRD(D0, VB, A) const s16x4 A##l0 = tr_read<v_rd_off(D0, 0, 0)>(VB), A##h0 = tr_read<v_rd_off(D0, 0, 1)>(VB), A##l1 = tr_read<v_rd_off(D0, 1, 0)>(VB), A##h1 = tr_read<v_rd_off(D0, 1, 1)>(VB), \
      A##l2 = tr_read<v_rd_off(D0 + 1, 0, 0)>(VB), A##h2 = tr_read<v_rd_off(D0 + 1, 0, 1)>(VB), A##l3 = tr_read<v_rd_off(D0 + 1, 1, 0)>(VB), A##h3 = tr_read<v_rd_off(D0 + 1, 1, 1)>(VB)
#define PK(L, H) (bf16x8){L[0], L[1], L[2], L[3], H[0], H[1], H[2], H[3]}
#define PVMM(OA, OB, A) do { OA = __builtin_amdgcn_mfma_f32_32x32x16_bf16(pa0, PK(A##l0, A##h0), OA, 0, 0, 0); OB = __builtin_amdgcn_mfma_f32_32x32x16_bf16(pa0, PK(A##l2, A##h2), OB, 0, 0, 0); \
      OA = __builtin_amdgcn_mfma_f32_32x32x16_bf16(pa1, PK(A##l1, A##h1), OA, 0, 0, 0); OB = __builtin_amdgcn_mfma_f32_32x32x16_bf16(pa1, PK(A##l3, A##h3), OB, 0, 0, 0); } while (0)
      const int vb2 = vb + SUB;
      PVRD(0, vb, A); PVRD(2, vb, B);
      asm volatile("s_waitcnt lgkmcnt(8)" ::: "memory"); SBAR(); PVMM(o[0], o[1], A); SBAR();
      PVRD(0, vb2, C);
      asm volatile("s_waitcnt lgkmcnt(8)" ::: "memory"); SBAR(); PVMM(o[2], o[3], B); SBAR();
      PVRD(2, vb2, D);
      asm volatile("s_waitcnt lgkmcnt(8)" ::: "memory"); SBAR(); PVMM(o[4], o[5], C); SBAR();
      asm volatile("s_waitcnt lgkmcnt(0)" ::: "memory"); SBAR(); PVMM(o[6], o[7], D);
#undef PVRD
#undef PK
#undef PVMM
    }
    __syncthreads();
  }
  if (hi == 0) { li_l[r32] = l_reg; al_l[r32] = m_reg; }
  __syncthreads();
  const float* sall = (const float*)(lds + ATT_WS);
  { const int wp = wid ^ 4;
    float fs[16];
#pragma unroll
    for (int r = 0; r < 16; ++r) { const int q = crow(r, hi);
      const float m0 = sall[wid * 64 + 32 + q], m1 = sall[wp * 64 + 32 + q], l0 = sall[wid * 64 + q], l1 = sall[wp * 64 + q];
      const float mm = fmaxf(m0, m1), f0 = __builtin_amdgcn_exp2f((m0 - mm) * C), f1 = __builtin_amdgcn_exp2f((m1 - mm) * C);
      fs[r] = f0 * __builtin_amdgcn_rcpf(l0 * f0 + l1 * f1) * (map ? -lam : 1.f); }
    unsigned short* Ob = (unsigned short*)lds + wid * 8192;
#pragma unroll
    for (int r = 0; r < 16; ++r) { const int orow = crow(r, hi);
#pragma unroll
      for (int d0 = 0; d0 < 8; ++d0) Ob[orow * 256 + d0 * 32 + r32] = (unsigned short)(cvtpk(o[d0][r] * fs[r], 0.f) & 0xffffu); } }
  __syncthreads();
#pragma unroll 2
  for (int rr = 0; rr < 8; ++rr) {
    const int row = wid * 8 + rr, rg2 = row >> 5, r5 = row & 31, c4 = lane * 4;
    float e0 = 0.f, e1 = 0.f, e2 = 0.f, e3 = 0.f;
#pragma unroll
    for (int ww = 0; ww < 4; ++ww) { const u32x2 v = *(const u32x2*)((const unsigned short*)lds + (rg2 + 2 * ww) * 8192 + r5 * 256 + c4);
      e0 += __uint_as_float(v.x << 16); e1 += __uint_as_float(v.x & 0xffff0000u); e2 += __uint_as_float(v.y << 16); e3 += __uint_as_float(v.y & 0xffff0000u); }
    const float ssq = wave_sum((e0 * e0 + e1 * e1) + (e2 * e2 + e3 * e3)); const float rstd = rsqrtf(ssq * (1.f / 256.f) + 1e-6f) * 0.8f;
    const long grow = rowbase + qc * 64 + row; const f32x4 g = *(const f32x4*)(hnorm + h * 256 + c4);
    const u32x2 zz = *(const u32x2*)(proj + grow * LDP + 6144 + h * 256 + c4);
    u32x2 w; w.x = cvtpk(e0 * rstd * g[0] * __uint_as_float(zz.x << 16), e1 * rstd * g[1] * __uint_as_float(zz.x & 0xffff0000u));
    w.y = cvtpk(e2 * rstd * g[2] * __uint_as_float(zz.y << 16), e3 * rstd * g[3] * __uint_as_float(zz.y & 0xffff0000u));
    *(u32x2*)(ymix + grow * 4096 + h * 256 + c4) = w; }
  __syncthreads();
#undef DMAKV
#undef DMAK_
#undef DMAV_
}
__device__ __forceinline__ void sgu_unit(int n, int g, const bf16* __restrict__ proj, bf16* __restrict__ ymix, const bf16* __restrict__ Wsb, const float* __restrict__ vsum, const float* __restrict__ vsq,
                                         const float* __restrict__ ln_g, const float* __restrict__ ln_b, const float* __restrict__ b_s, char* lds) {
  int tid_ = threadIdx.x; asm volatile("" : "+v"(tid_)); const int tid = tid_, wid = __builtin_amdgcn_readfirstlane(tid >> 6), lane = tid & 63, r32 = lane & 31, hi = lane >> 5;
  unsigned short* vT = (unsigned short*)lds;
  float* mean_l = (float*)(lds + 256 * 136 * 2); float* rstd_l = mean_l + 128;
  const long t0 = (long)n * 128; const int c0 = g * 256;
  if (tid < 128) { const float m = vsum[t0 + tid] * (1.f / 2048.f); const float var = vsq[t0 + tid] * (1.f / 2048.f) - m * m; mean_l[tid] = m; rstd_l[tid] = rsqrtf(fmaxf(var, 0.f) + 1e-6f); }
  __syncthreads();
#pragma unroll 4
  for (int k = 0; k < 8; ++k) { const int t = (tid & 63) + 64 * (k & 1), c = ((tid >> 6) + 8 * (k >> 1)) * 8;
    const u32x4 raw = *(const u32x4*)(proj + (t0 + t) * LDP + 10240 + c0 + c);
    const f32x4 g0 = *(const f32x4*)(ln_g + c0 + c), g1 = *(const f32x4*)(ln_g + c0 + c + 4), b0 = *(const f32x4*)(ln_b + c0 + c), b1 = *(const f32x4*)(ln_b + c0 + c + 4);
    const float mu = mean_l[t], rs = rstd_l[t];
    float v[8] = {__uint_as_float(raw.x << 16), __uint_as_float(raw.x & 0xffff0000u), __uint_as_float(raw.y << 16), __uint_as_float(raw.y & 0xffff0000u),
                  __uint_as_float(raw.z << 16), __uint_as_float(raw.z & 0xffff0000u), __uint_as_float(raw.w << 16), __uint_as_float(raw.w & 0xffff0000u)};
#pragma unroll
    for (int e = 0; e < 8; ++e) { const float gg = e < 4 ? g0[e & 3] : g1[e & 3], bb = e < 4 ? b0[e & 3] : b1[e & 3];
      const float val = (v[e] - mu) * rs * gg + bb; vT[(c + e) * 136 + t] = (unsigned short)(cvtpk(val, 0.f) & 0xffffu); } }
  __syncthreads();
  f32x16 acc[4] = {};
#pragma unroll 4
  for (int ks = 0; ks < 8; ++ks) { const bf16x8 B = *(const bf16x8*)(vT + (32 * wid + r32) * 136 + ks * 16 + hi * 8);
#pragma unroll
    for (int m = 0; m < 4; ++m) { const bf16x8 A = *(const bf16x8*)(Wsb + g * 16384 + (32 * m + r32) * 128 + ks * 16 + hi * 8);
      acc[m] = __builtin_amdgcn_mfma_f32_32x32x16_bf16(A, B, acc[m], 0, 0, 0); } }
  __syncthreads();
  unsigned short* mx = (unsigned short*)lds;
#pragma unroll
  for (int m = 0; m < 4; ++m)
#pragma unroll
    for (int r = 0; r < 16; ++r) { const int i = 32 * m + crow(r, hi);
      mx[i * 264 + 32 * wid + r32] = (unsigned short)(cvtpk(acc[m][r] + b_s[g * 128 + i], 0.f) & 0xffffu); }
  __syncthreads();
#pragma unroll 8
  for (int k = 0; k < 8; ++k) { const int item = tid + 512 * k, i = item >> 5, c = (item & 31) * 8; const long row = t0 + i;
    const u32x4 uu = *(const u32x4*)(proj + row * LDP + 8192 + c0 + c), zz = *(const u32x4*)(proj + row * LDP + 12288 + c0 + c), mm = *(const u32x4*)(mx + i * 264 + c);
    u32x4 o;
#define LO(x) __uint_as_float((x) << 16)
#define HI(x) __uint_as_float((x) & 0xffff0000u)
    o.x = cvtpk(LO(uu.x) * LO(mm.x) * LO(zz.x), HI(uu.x) * HI(mm.x) * HI(zz.x)); o.y = cvtpk(LO(uu.y) * LO(mm.y) * LO(zz.y), HI(uu.y) * HI(mm.y) * HI(zz.y));
    o.z = cvtpk(LO(uu.z) * LO(mm.z) * LO(zz.z), HI(uu.z) * HI(mm.z) * HI(zz.z)); o.w = cvtpk(LO(uu.w) * LO(mm.w) * LO(zz.w), HI(uu.w) * HI(mm.w) * HI(zz.w));
#undef LO
#undef HI
    *(u32x4*)(ymix + row * 4096 + 2048 + c0 + c) = o; }
  __syncthreads();
}
}
#define LAS __attribute__((address_space(3)))
typedef unsigned short bf16;
typedef unsigned v4u __attribute__((ext_vector_type(4)));
typedef unsigned v2u __attribute__((ext_vector_type(2)));
typedef float f32x4 __attribute__((ext_vector_type(4)));
typedef float f32x16 __attribute__((ext_vector_type(16)));
typedef short bf16x8 __attribute__((ext_vector_type(8)));
constexpr int NWAVES = 8;
constexpr int M = 8192, DM = 2048, SEQ = 4096, NIN = 14336, NMIX = 4096, CW = 2688, NCIN = 5376;
constexpr size_t MiB = 1u << 20;
constexpr size_t WS_STATS = 0;
constexpr size_t WS_SUMA = 1 * MiB, WS_SUMH = 3 * MiB;
constexpr size_t WS_WGT = 5 * MiB;
constexpr size_t WS_WSB = 8 * MiB;
constexpr size_t WS_WTOUT = 9 * MiB;
constexpr size_t WS_WTCIN = 25 * MiB;
constexpr size_t WS_WTCOUT = 46 * MiB;
constexpr size_t WS_WTIN = 57 * MiB;
constexpr size_t WS_XN = 113 * MiB;
constexpr size_t WS_YMIX = 57 * MiB, WS_YMIX2 = 57 * MiB;
constexpr size_t WS_PROJ = 145 * MiB;
constexpr size_t WS_X1B = 145 * MiB;
constexpr size_t WS_PROJ2 = 177 * MiB;
constexpr size_t WS_HL = 261 * MiB, WS_PP = 303 * MiB;
constexpr size_t WS_KVIMG = 369 * MiB;
constexpr size_t WS_END = 433 * MiB;
constexpr int LDS_BYTES = 147456;

__device__ __forceinline__ unsigned f2bf(float f) { unsigned u = __builtin_bit_cast(unsigned, f); return (u + 0x7fffu + ((u >> 16) & 1u)) >> 16; }
__device__ __forceinline__ unsigned pk2(float lo, float hi) { return f2bf(lo) | (f2bf(hi) << 16); }
__device__ __forceinline__ float bf2f(unsigned short s) { return __uint_as_float((unsigned)s << 16); }
__device__ __forceinline__ float wave_sum(float v) {
#pragma unroll
    for (int o = 1; o < 64; o <<= 1) v += __shfl_xor(v, o);
    return v;
}
__device__ __forceinline__ int crow(int r, int hi) { return (r & 3) + 8 * (r >> 2) + 4 * hi; }

__device__ __forceinline__ void p0_tr_load(const float* __restrict__ W, int N, int nblk, int item, int lane, f32x4 (&v)[8]) {
    const int kb = item / nblk, nb = item - kb * nblk; const float* p = W + (size_t)(64 * kb + (lane >> 3)) * N + 32 * nb + (lane & 7) * 4;
#pragma unroll
    for (int i = 0; i < 8; ++i) v[i] = __builtin_nontemporal_load((const f32x4*)(p + (size_t)(8 * i) * N));
}
__device__ __forceinline__ void p0_tr_store(int K, int nblk, bf16* __restrict__ WT, const float* __restrict__ kscale, float* scr, int item, int lane, const f32x4 (&v)[8]) {
    const int kb = item / nblk, nb = item - kb * nblk, k0 = 64 * kb, n0 = 32 * nb;
#pragma unroll
    for (int i = 0; i < 8; ++i) { const int kk = 8 * i + (lane >> 3); const float sc = kscale ? kscale[k0 + kk] : 1.f; float* d = scr + kk * 33 + (lane & 7) * 4;
        d[0] = v[i][0] * sc; d[1] = v[i][1] * sc; d[2] = v[i][2] * sc; d[3] = v[i][3] * sc; }
    asm volatile("s_waitcnt lgkmcnt(0)" ::: "memory");
    const int c = lane & 7;
#pragma unroll
    for (int j = 0; j < 4; ++j) { const int n = (lane >> 3) + 8 * j; const float* s = scr + (8 * c) * 33 + n;
        v4u o; o.x = pk2(s[0 * 33], s[1 * 33]); o.y = pk2(s[2 * 33], s[3 * 33]); o.z = pk2(s[4 * 33], s[5 * 33]); o.w = pk2(s[6 * 33], s[7 * 33]);
        *(v4u*)(WT + (size_t)(n0 + n) * K + k0 + 8 * c) = o; }
    asm volatile("s_waitcnt lgkmcnt(0)" ::: "memory");
}
__device__ __forceinline__ void p0_transpose_matrix(const float* __restrict__ W, int K, int N, bf16* __restrict__ WT, const float* __restrict__ kscale, float* scr, int lane, int first, int stride) {
    const int nblk = N / 32, nitems = (K / 64) * nblk;
    f32x4 va[8], vb[8];
    int it = first;
    if (it < nitems) p0_tr_load(W, N, nblk, it, lane, va);
    while (it < nitems) {
        const int it2 = it + stride;
        if (it2 < nitems) p0_tr_load(W, N, nblk, it2, lane, vb);
        p0_tr_store(K, nblk, WT, kscale, scr, it, lane, va);
        if (it2 >= nitems) break;
        const int it3 = it2 + stride;
        if (it3 < nitems) p0_tr_load(W, N, nblk, it3, lane, va);
        p0_tr_store(K, nblk, WT, kscale, scr, it2, lane, vb);
        it = it3;
    }
}


#define RLX_AGENT __ATOMIC_RELAXED, __HIP_MEMORY_SCOPE_AGENT
#define XB_TMO      128
#define XB_XCNT(j)  (256  + 64 * (j))
#define XB_XSUB(j)  (1280 + 64 * (j))
#define XB_XGEN(j)  (2304 + 64 * (j))
#define XB_TOP      3328
#define XB_TOPGEN   3392
#define XCD_BAR_WORDS 3456
#define XB_SPIN_CAP (1u << 18)

__device__ __forceinline__ unsigned xb_ld(unsigned* p)              { return __hip_atomic_load(p, __ATOMIC_RELAXED, __HIP_MEMORY_SCOPE_AGENT); }
__device__ __forceinline__ unsigned xb_add(unsigned* p, unsigned v) { return __hip_atomic_fetch_add(p, v, __ATOMIC_RELAXED, __HIP_MEMORY_SCOPE_AGENT); }
__device__ __forceinline__ unsigned xb_xcc_id() { return (unsigned)__builtin_amdgcn_s_getreg((3 << 11) | 20) & 0xFu; }
#define XB_SPIN(cond, bar) do { unsigned _sp = 0; while (cond) { __builtin_amdgcn_s_sleep(1); \
    if ((++_sp & 255u) == 0u) { if (xb_ld(&(bar)[XB_TMO])) break; if (_sp > XB_SPIN_CAP) { atomicAdd(&(bar)[XB_TMO], 1u); break; } } } } while (0)

struct XcdBarrier {
    unsigned* bar; unsigned x;
    volatile LAS unsigned* st;
};

__device__ __forceinline__ XcdBarrier xcd_barrier_post(unsigned* bar, volatile LAS unsigned* st) {
    XcdBarrier b; b.bar = bar; b.x = xb_xcc_id(); b.st = st;
    if (threadIdx.x == 0) (void)xb_add(&bar[XB_XCNT(b.x)], 1u);
    return b;
}
__device__ __forceinline__ void xcd_barrier_complete(unsigned* bar, unsigned x, unsigned& nloc, unsigned& nx) {
    const unsigned G = gridDim.x * gridDim.y * gridDim.z;
    unsigned sum, cnt, mine, sp = 0u;
    for (;;) {
        sum = 0u; cnt = 0u; mine = 0u;
#pragma unroll
        for (unsigned j = 0; j < 16; ++j) { const unsigned c = xb_ld(&bar[XB_XCNT(j)]); sum += c; cnt += (c > 0u) ? 1u : 0u; mine = (j == x) ? c : mine; }
        if (sum == G) break;
        __builtin_amdgcn_s_sleep(1);
        if ((++sp & 255u) == 0u) { if (xb_ld(&bar[XB_TMO])) break; if (sp > XB_SPIN_CAP) { atomicAdd(&bar[XB_TMO], 1u); break; } }
    }
    nloc = mine > 0u ? mine : 1u; nx = cnt > 0u ? cnt : 1u;
}

__device__ __forceinline__ void xcd_barrier(const XcdBarrier& b) {
    asm volatile("s_waitcnt vmcnt(0)" ::: "memory");
    __syncthreads();
    if (threadIdx.x == 0) {
        unsigned* bar = b.bar;
        __builtin_amdgcn_s_waitcnt(0);
        unsigned nloc = b.st[0], nx = b.st[1];
        if (nloc == 0u) { xcd_barrier_complete(bar, b.x, nloc, nx); b.st[0] = nloc; b.st[1] = nx; }
        const unsigned old = xb_add(&bar[XB_XSUB(b.x)], 1u);
        const unsigned gen = old / nloc;
        if (old + 1u == (gen + 1u) * nloc) {
            __builtin_amdgcn_fence(__ATOMIC_RELEASE, "agent");
            asm volatile("s_waitcnt vmcnt(0)" ::: "memory");
            const unsigned og = xb_add(&bar[XB_TOP], 1u);
            const unsigned tg = og / nx;
            if (og + 1u == (tg + 1u) * nx) xb_add(&bar[XB_TOPGEN], 1u);
            else XB_SPIN(xb_ld(&bar[XB_TOPGEN]) == tg, bar);
            __builtin_amdgcn_fence(__ATOMIC_ACQUIRE, "agent");
            xb_add(&bar[XB_XGEN(b.x)], 1u);
            asm volatile("s_waitcnt vmcnt(0)" ::: "memory");
        } else {
            XB_SPIN(xb_ld(&bar[XB_XGEN(b.x)]) == gen, bar);
            __builtin_amdgcn_fence(__ATOMIC_ACQUIRE, "agent");
            asm volatile("s_waitcnt vmcnt(0)" ::: "memory");
        }
    }
    __syncthreads();
}

constexpr size_t WS_ACTR = 512 * 1024 + 49152;
constexpr size_t WS_GCNT = 512 * 1024 + 32768;
constexpr size_t WS_PCNT = 512 * 1024 + 16384;
constexpr size_t WS_BAR = 512 * 1024;
struct Args { const float* in[21]; float* out; unsigned char* ws; int ph_lo, ph_hi; };

typedef __attribute__((address_space(4))) const volatile unsigned long long* kaq_t;
#define LK_F(i) ((const float*)(const __attribute__((address_space(1))) float*)(kap[(i)]))
__device__ __forceinline__ void lru_group(int b, int hd, int tc0, kaq_t kap, unsigned char* ws, char* lds) {
    const int grp = (b * 16 + hd) * 8 + (tc0 >> 3), gsub = tc0 >> 3;
    int tid_ = threadIdx.x; asm volatile("" : "+v"(tid_)); const int tid = tid_, wid = __builtin_amdgcn_readfirstlane(tid >> 6), lane = tid & 63, r32 = lane & 31, hi = lane >> 5;
    bf16* xraw = (bf16*)lds;
    bf16* xcb = (bf16*)(lds + 22528);
    float* xcf = (float*)(lds + 48128);
    bf16* hlb = (bf16*)(lds + 91136);
    bf16* ppb = (bf16*)(lds + 112640);
    for (int idx = tid; idx < 64 * 4; idx += 512) *(v4u*)(xcb + (idx >> 2) * 200 + 168 + (idx & 3) * 8) = (v4u){0u, 0u, 0u, 0u};
    float* cwl = (float*)(lds + 134848);
    { const float* cw_ = LK_F(12); const float* cb_ = LK_F(13);
      for (int idx = tid; idx < 5 * 168; idx += 512) { const int k = idx / 168, c = idx - k * 168; cwl[idx] = k < 4 ? cw_[k * CW + hd * 168 + c] : cb_[hd * 168 + c]; } }
    const int j = 32 * wid + r32, jc = j < 168 ? j : 167, Cj = hd * 168 + jc;
    bf16x8 Br[12], Bi[12]; float ba = 0.f, bx = 0.f, sp = 0.f;
    if (wid < 6) { const bf16* wr_ = (const bf16*)(ws + WS_WGT) + ((size_t)(hd * 2 + 0) * 192 + j) * 192 + hi * 8; const bf16* wi_ = wr_ + 192 * 192;
#pragma unroll
        for (int ks = 0; ks < 12; ++ks) { Br[ks] = *(const bf16x8*)(wr_ + ks * 16); Bi[ks] = *(const bf16x8*)(wi_ + ks * 16); }
        ba = -1.4426950408889634f * LK_F(15)[Cj]; bx = -1.4426950408889634f * LK_F(17)[Cj]; sp = -8.f * 1.4426950408889634f * log1pf(__expf(-LK_F(18)[Cj])); }
    float c = 0.f, Q = 1.f;
    v4u hv0, hv1, hv2;
#define HALO_LD(TC) do { const bf16* p2_ = (const bf16*)(ws + WS_PROJ2) + (long)b * SEQ * NCIN + hd * 168; \
        { const int it_ = tid, tr_ = it_ / 21, v_ = it_ - tr_ * 21, tl_ = (TC) * 64 + tr_ - 3; hv0 = (v4u){0u, 0u, 0u, 0u}; if (tl_ >= 0) hv0 = *(const v4u*)(p2_ + (long)tl_ * NCIN + v_ * 8); } \
        { const int it_ = tid + 512, tr_ = it_ / 21, v_ = it_ - tr_ * 21, tl_ = (TC) * 64 + tr_ - 3; hv1 = (v4u){0u, 0u, 0u, 0u}; if (tl_ >= 0) hv1 = *(const v4u*)(p2_ + (long)tl_ * NCIN + v_ * 8); } \
        { const int it_ = tid + 1024, tr_ = it_ / 21, v_ = it_ - tr_ * 21, tl_ = (TC) * 64 + tr_ - 3; hv2 = (v4u){0u, 0u, 0u, 0u}; if (it_ < 67 * 21 && tl_ >= 0) hv2 = *(const v4u*)(p2_ + (long)tl_ * NCIN + v_ * 8); } } while (0)
#define HALO_ST() do { { const int it_ = tid, tr_ = it_ / 21, v_ = it_ - tr_ * 21; *(v4u*)(xraw + tr_ * 168 + v_ * 8) = hv0; } \
        { const int it_ = tid + 512, tr_ = it_ / 21, v_ = it_ - tr_ * 21; *(v4u*)(xraw + tr_ * 168 + v_ * 8) = hv1; } \
        { const int it_ = tid + 1024, tr_ = it_ / 21, v_ = it_ - tr_ * 21; if (it_ < 67 * 21) *(v4u*)(xraw + tr_ * 168 + v_ * 8) = hv2; } } while (0)
    HALO_LD(tc0); HALO_ST(); HALO_LD(tc0 + 1);
    __syncthreads();
#pragma unroll 1
    for (int ci = 0; ci < 8; ++ci) { const int tc = tc0 + ci; const long row0 = (long)b * SEQ + tc * 64;
        if (ci > 0) { const long rowp = row0 - 64;
            for (int it = tid; it < 64 * 21; it += 512) { const int t = it / 21, v = it - t * 21, C = hd * 168 + v * 8;
                __builtin_nontemporal_store(*(const v4u*)(hlb + t * 168 + v * 8), (v4u*)((bf16*)(ws + WS_HL) + (rowp + t) * CW + C)); __builtin_nontemporal_store(*(const v4u*)(ppb + t * 168 + v * 8), (v4u*)((bf16*)(ws + WS_PP) + (rowp + t) * CW + C)); } }
        for (int it = tid; it < 64 * 21; it += 512) { const int t = it / 21, v = it - t * 21;
            f32x4 a0 = *(const f32x4*)(cwl + 4 * 168 + v * 8), a1 = *(const f32x4*)(cwl + 4 * 168 + v * 8 + 4);
#pragma unroll
            for (int k = 0; k < 4; ++k) { const v4u xr = *(const v4u*)(xraw + (t + k) * 168 + v * 8); const f32x4 w0 = *(const f32x4*)(cwl + k * 168 + v * 8), w1 = *(const f32x4*)(cwl + k * 168 + v * 8 + 4);
                a0[0] += w0[0] * __uint_as_float(xr.x << 16); a0[1] += w0[1] * __uint_as_float(xr.x & 0xffff0000u); a0[2] += w0[2] * __uint_as_float(xr.y << 16); a0[3] += w0[3] * __uint_as_float(xr.y & 0xffff0000u);
                a1[0] += w1[0] * __uint_as_float(xr.z << 16); a1[1] += w1[1] * __uint_as_float(xr.z & 0xffff0000u); a1[2] += w1[2] * __uint_as_float(xr.w << 16); a1[3] += w1[3] * __uint_as_float(xr.w & 0xffff0000u); }
            v4u o; o.x = pk2(a0[0], a0[1]); o.y = pk2(a0[2], a0[3]); o.z = pk2(a1[0], a1[1]); o.w = pk2(a1[2], a1[3]);
            *(v4u*)(xcb + t * 200 + v * 8) = o; *(f32x4*)(xcf + t * 168 + v * 8) = a0; *(f32x4*)(xcf + t * 168 + v * 8 + 4) = a1; }
        __syncthreads();
        if (ci < 7) { HALO_ST(); if (ci < 6) HALO_LD(tc + 2); }
        if (wid < 6) {
#pragma unroll 1
            for (int m = 0; m < 2; ++m) {
                f32x16 accr = {}, acci = {};
#pragma unroll
                for (int ks = 0; ks < 12; ++ks) { const bf16x8 A = *(const bf16x8*)(xcb + (32 * m + r32) * 200 + ks * 16 + hi * 8);
                    accr = __builtin_amdgcn_mfma_f32_32x32x16_bf16(A, Br[ks], accr, 0, 0, 0); acci = __builtin_amdgcn_mfma_f32_32x32x16_bf16(A, Bi[ks], acci, 0, 0, 0); }
#pragma unroll
                for (int q = 0; q < 4; ++q) { float Pe[4], He[4]; float P = 1.f, h = 0.f; const int tb = 32 * m + 8 * q + 4 * hi;
#pragma unroll
                    for (int e = 0; e < 4; ++e) { const int r = 4 * q + e;
                        const float rg = __builtin_amdgcn_rcpf(1.f + __builtin_amdgcn_exp2f(fmaf(accr[r], -1.4426950408889634f, ba))), ig = __builtin_amdgcn_rcpf(1.f + __builtin_amdgcn_exp2f(fmaf(acci[r], -1.4426950408889634f, bx)));
                        const float a = __builtin_amdgcn_exp2f(rg * sp), beta = __builtin_amdgcn_sqrtf(fmaxf(fmaf(-a, a, 1.f), 0.f));
                        const float bt = beta * ig * xcf[(tb + e) * 168 + j];
                        h = a * h + bt; P *= a; Pe[e] = P; He[e] = h; }
                    const float Ap = __shfl_xor(P, 32), Hp = __shfl_xor(h, 32);
                    const float Af = hi ? Ap : P, Hf = hi ? Hp : h, As = hi ? P : Ap, Hs = hi ? h : Hp;
                    const float c1 = Af * c + Hf, Q1 = Af * Q; const float cin = hi ? c1 : c, qin = hi ? Q1 : Q; c = As * c1 + Hs; Q = As * Q1;
                    if (j < 168) {
#pragma unroll
                        for (int e = 0; e < 4; e += 2) { const unsigned hh = pg8::cvt_pk_bf16(fmaf(Pe[e], cin, He[e]), fmaf(Pe[e + 1], cin, He[e + 1])), pq = pg8::cvt_pk_bf16(Pe[e] * qin, Pe[e + 1] * qin);
                            hlb[(tb + e) * 168 + j] = (bf16)(hh & 0xffffu); hlb[(tb + e + 1) * 168 + j] = (bf16)(hh >> 16); ppb[(tb + e) * 168 + j] = (bf16)(pq & 0xffffu); ppb[(tb + e + 1) * 168 + j] = (bf16)(pq >> 16); } }
                }
            }
        }
        __syncthreads();
    }
    { const long rowp = (long)b * SEQ + (tc0 + 7) * 64;
        for (int it = tid; it < 64 * 21; it += 512) { const int t = it / 21, v = it - t * 21, C = hd * 168 + v * 8;
            __builtin_nontemporal_store(*(const v4u*)(hlb + t * 168 + v * 8), (v4u*)((bf16*)(ws + WS_HL) + (rowp + t) * CW + C)); __builtin_nontemporal_store(*(const v4u*)(ppb + t * 168 + v * 8), (v4u*)((bf16*)(ws + WS_PP) + (rowp + t) * CW + C)); } }
    float* carr = (float*)(lds + 134144);
    float* grpA = (float*)(ws + WS_SUMA); float* grpH = (float*)(ws + WS_SUMH); unsigned* gcnt = (unsigned*)(ws + WS_GCNT);
    if (wid < 6) {
        if (hi == 0 && j < 168) { __hip_atomic_store(grpA + (size_t)grp * 168 + j, Q, __ATOMIC_RELAXED, __HIP_MEMORY_SCOPE_AGENT); __hip_atomic_store(grpH + (size_t)grp * 168 + j, c, __ATOMIC_RELAXED, __HIP_MEMORY_SCOPE_AGENT); }
        asm volatile("s_waitcnt vmcnt(0)" ::: "memory");
        if (lane == 0) __hip_atomic_fetch_add(gcnt + 16 * grp, 1u, __ATOMIC_RELAXED, __HIP_MEMORY_SCOPE_AGENT);
        float cy = 0.f;
        { const int g0 = grp - gsub;
          unsigned sp = 0;
          for (;;) { unsigned mn_ = 6u;
#pragma unroll
            for (int k = 0; k < 7; ++k) if (k < gsub) { const unsigned v_ = __hip_atomic_load(gcnt + 16 * (g0 + k), __ATOMIC_RELAXED, __HIP_MEMORY_SCOPE_AGENT); mn_ = v_ < mn_ ? v_ : mn_; }
            if (mn_ >= 6u || ++sp > (1u << 20)) break; __builtin_amdgcn_s_sleep(2); }
          float A2[7], H2[7];
#pragma unroll
          for (int k = 0; k < 7; ++k) { A2[k] = 1.f; H2[k] = 0.f; if (k < gsub) { A2[k] = __hip_atomic_load(grpA + (size_t)(g0 + k) * 168 + jc, __ATOMIC_RELAXED, __HIP_MEMORY_SCOPE_AGENT); H2[k] = __hip_atomic_load(grpH + (size_t)(g0 + k) * 168 + jc, __ATOMIC_RELAXED, __HIP_MEMORY_SCOPE_AGENT); } }
#pragma unroll
          for (int k = 0; k < 7; ++k) cy = A2[k] * cy + H2[k]; }
        if (hi == 0 && j < 168) carr[j] = cy;
    }
    __builtin_amdgcn_fence(__ATOMIC_ACQUIRE, "agent");
    __syncthreads();
    { const long rowg = (long)b * SEQ + tc0 * 64; const bf16* HLp = (const bf16*)(ws + WS_HL); const bf16* PPp = (const bf16*)(ws + WS_PP); const bf16* P2p = (const bf16*)(ws + WS_PROJ2); bf16* Y2 = (bf16*)(ws + WS_YMIX2);
#pragma unroll 7
        for (int it = tid; it < 512 * 21; it += 512) { const int t = it / 21, v = it - t * 21, C = hd * 168 + v * 8; const long row = rowg + t;
            const v4u hl = __builtin_nontemporal_load((const v4u*)(HLp + row * CW + C)), pp = __builtin_nontemporal_load((const v4u*)(PPp + row * CW + C)), sz = __builtin_nontemporal_load((const v4u*)(P2p + row * NCIN + CW + C));
            const f32x4 c0 = *(const f32x4*)(carr + v * 8), c1 = *(const f32x4*)(carr + v * 8 + 4);
            v4u o;
#define LO(x) __uint_as_float((x) << 16)
#define HI(x) __uint_as_float((x) & 0xffff0000u)
            o.x = pk2((LO(hl.x) + LO(pp.x) * c0[0]) * LO(sz.x), (HI(hl.x) + HI(pp.x) * c0[1]) * HI(sz.x));
            o.y = pk2((LO(hl.y) + LO(pp.y) * c0[2]) * LO(sz.y), (HI(hl.y) + HI(pp.y) * c0[3]) * HI(sz.y));
            o.z = pk2((LO(hl.z) + LO(pp.z) * c1[0]) * LO(sz.z), (HI(hl.z) + HI(pp.z) * c1[1]) * HI(sz.z));
            o.w = pk2((LO(hl.w) + LO(pp.w) * c1[2]) * LO(sz.w), (HI(hl.w) + HI(pp.w) * c1[3]) * HI(sz.w));
#undef LO
#undef HI
            *(v4u*)(Y2 + row * CW + C) = o; } }
    __syncthreads();
}
__device__ __forceinline__ void carry_unit(int u, const bf16* __restrict__ HL, const bf16* __restrict__ PP, const bf16* __restrict__ proj2, const float* __restrict__ sumA, const float* __restrict__ sumH,
                                           bf16* __restrict__ ymix2, char* lds) {
    int tid_ = threadIdx.x; asm volatile("" : "+v"(tid_)); const int tid = tid_; const int chunk = u >> 1, half = u & 1, b = chunk >> 6, cbase = half * 1344;
    float* carry = (float*)lds;
    for (int c = tid; c < 1344; c += 512) { const int C = cbase + c; float h = 0.f;
#pragma unroll 8
        for (int cc = b * 64; cc < chunk; ++cc) h = sumA[(size_t)cc * CW + C] * h + sumH[(size_t)cc * CW + C];
        carry[c] = h; }
    __syncthreads();
    for (int it = tid; it < 64 * 168; it += 512) { const int t = it / 168, v = it - t * 168; const long row = (long)chunk * 64 + t; const int C = cbase + v * 8;
        const v4u hl = *(const v4u*)(HL + row * CW + C), pp = *(const v4u*)(PP + row * CW + C), sz = *(const v4u*)(proj2 + row * NCIN + CW + C);
        const f32x4 c0 = *(const f32x4*)(carry + v * 8), c1 = *(const f32x4*)(carry + v * 8 + 4);
        v4u o;
#define LO(x) __uint_as_float((x) << 16)
#define HI(x) __uint_as_float((x) & 0xffff0000u)
        o.x = pk2((LO(hl.x) + LO(pp.x) * c0[0]) * LO(sz.x), (HI(hl.x) + HI(pp.x) * c0[1]) * HI(sz.x));
        o.y = pk2((LO(hl.y) + LO(pp.y) * c0[2]) * LO(sz.y), (HI(hl.y) + HI(pp.y) * c0[3]) * HI(sz.y));
        o.z = pk2((LO(hl.z) + LO(pp.z) * c1[0]) * LO(sz.z), (HI(hl.z) + HI(pp.z) * c1[1]) * HI(sz.z));
        o.w = pk2((LO(hl.w) + LO(pp.w) * c1[2]) * LO(sz.w), (HI(hl.w) + HI(pp.w) * c1[3]) * HI(sz.w));
#undef LO
#undef HI
        *(v4u*)(ymix2 + row * CW + C) = o; }
    __syncthreads();
}

__global__ void __launch_bounds__(NWAVES * 64, 2) mk_fwd(Args args) {
    extern __shared__ __attribute__((aligned(16))) unsigned char lds[];
#define PH_IDS() int tid_ = threadIdx.x; asm volatile("" : "+v"(tid_)); const int tid = tid_, lane = tid & 63, wave = __builtin_amdgcn_readfirstlane(tid >> 6); (void)lane; (void)wave; \
    const int gw = vcu * NWAVES + wave, NGW = G * NWAVES; const int gt = bx * 512 + tid, NGT = G * 512; (void)gw; (void)NGW; (void)gt; (void)NGT;
    const int G = gridDim.x; const int bx = blockIdx.x; const int vcu = (G % 8 == 0) ? (bx % 8) * (G / 8) + bx / 8 : bx;
    typedef const float* cfp; typedef __attribute__((address_space(4))) const volatile unsigned long long* kaq;
    const kaq kap = (kaq)__builtin_amdgcn_kernarg_segment_ptr();
#define GAS1 __attribute__((address_space(1)))
#define KIN(i) ((cfp)(const GAS1 float*)(kap[(i)]))
#define WSLOAD() ((unsigned char*)(GAS1 unsigned char*)(kap[22]))
#define K_x KIN(0)
#define K_ab_norm KIN(1)
#define K_ab_w_in KIN(2)
#define K_ab_lambda KIN(3)
#define K_ab_head_norm KIN(4)
#define K_sgu_ln_g KIN(5)
#define K_sgu_ln_b KIN(6)
#define K_sgu_w KIN(7)
#define K_sgu_b KIN(8)
#define K_ab_w_out KIN(9)
#define K_c_norm KIN(10)
#define K_c_w_in KIN(11)
#define K_c_conv_w KIN(12)
#define K_c_conv_b KIN(13)
#define K_c_gate_a_w KIN(14)
#define K_c_gate_a_b KIN(15)
#define K_c_gate_x_w KIN(16)
#define K_c_gate_x_b KIN(17)
#define K_c_lambda KIN(18)
#define K_c_w_out KIN(19)
#define K_final_norm KIN(20)
#define K_out ((float*)(GAS1 float*)(kap[21]))
#define ss1 ((float*)(ws + WS_STATS))
#define ss2 (ss1 + M)
#define vsum (ss1 + 2 * M)
#define vsq (ss1 + 3 * M)
#define sumA ((float*)(ws + WS_SUMA))
#define sumH ((float*)(ws + WS_SUMH))
#define WgT ((bf16*)(ws + WS_WGT))
#define Wsb ((bf16*)(ws + WS_WSB))
#define WtOut ((bf16*)(ws + WS_WTOUT))
#define WtCin ((bf16*)(ws + WS_WTCIN))
#define WtCout ((bf16*)(ws + WS_WTCOUT))
#define WtIn ((bf16*)(ws + WS_WTIN))
#define XN ((bf16*)(ws + WS_XN))
#define YMIX ((bf16*)(ws + WS_YMIX))
#define YMIX2 ((bf16*)(ws + WS_YMIX2))
#define PROJ ((bf16*)(ws + WS_PROJ))
#define X1B ((bf16*)(ws + WS_X1B))
#define PROJ2 ((bf16*)(ws + WS_PROJ2))
#define HL ((bf16*)(ws + WS_HL))
#define PP ((bf16*)(ws + WS_PP))
    const int lo = args.ph_lo, hi = args.ph_hi;
#if MK_N_LAUNCHES == 1
    volatile LAS unsigned* xst = (volatile LAS unsigned*)((LAS unsigned char*)lds + LDS_BYTES - 64);
    if (threadIdx.x < 2) xst[threadIdx.x] = 0u;
    __syncthreads();
    XcdBarrier xbar = xcd_barrier_post((unsigned*)(WSLOAD() + WS_BAR), xst);
    if (lo > hi) cg::this_grid().sync();
#endif
#ifndef REP_PHASE
#define REP_PHASE -1
#endif
#define REPN(k) ((k) == REP_PHASE ? 2 : 1)
#ifndef PH_MASK
#define PH_MASK 0x1ff
#endif
#define IN(k) (((PH_MASK >> (k)) & 1) && lo <= (k) && (k) < hi)
#if MK_N_LAUNCHES == 1
#define SEAM(k) do { if (IN(k) && IN((k) + 1)) { xcd_barrier(xbar); } } while (0)
#else
#define SEAM(k) do { } while (0)
#endif
#ifdef TPROBE_A
    volatile unsigned long long* tsl = (volatile unsigned long long*)(lds + LDS_BYTES - 128);
#define STAMP(k) do { if (bx == 0 && threadIdx.x == 0) tsl[(k)] = __builtin_amdgcn_s_memrealtime(); } while (0)
#else
#define STAMP(k) do { } while (0)
#endif
    STAMP(0);

    if (IN(0)) { unsigned char* const ws = WSLOAD(); PH_IDS();
        for (int i = gt; i < 4 * M; i += NGT) ss1[i] = 0.f;
        float* scr = (float*)(lds + wave * 16384);
        p0_transpose_matrix(K_ab_w_in, DM, NIN, WtIn, nullptr, scr, lane, gw, NGW);
        p0_transpose_matrix(K_ab_w_out, NMIX, DM, WtOut, nullptr, scr, lane, (gw + 517) % NGW, NGW);
        p0_transpose_matrix(K_c_w_in, DM, NCIN, WtCin, K_c_norm, scr, lane, (gw + 1031) % NGW, NGW);
        if (G != 256) p0_transpose_matrix(K_c_w_out, CW, DM, WtCout, nullptr, scr, lane, (gw + 1549) % NGW, NGW);
        if (G != 256) for (int i = gt; i < 16 * 2 * 192 * 192; i += NGT) { const int ii = i % 192, j = (i / 192) % 192, gate = (i / (192 * 192)) & 1, hd = i / (2 * 192 * 192);
            float v = 0.f; if (ii < 168 && j < 168) v = (gate ? K_c_gate_x_w : K_c_gate_a_w)[((size_t)hd * 168 + ii) * 168 + j];
            WgT[i] = (bf16)f2bf(v); }
        for (int i = gt; i < 8 * 128 * 128; i += NGT) { const int j = i & 127, ii = (i >> 7) & 127; Wsb[i] = ((ii >> 6) >= (j >> 6)) ? (bf16)f2bf(K_sgu_w[i]) : (bf16)0; }
        const float* x_ = K_x; const float* abn_ = K_ab_norm;
        for (int m_ = gw; m_ < M * REPN(0); m_ += NGW) { const int m = m_ % M;
            const f32x4* xr = (const f32x4*)(x_ + (size_t)m * DM) + lane; f32x4 v[8]; float s = 0.f;
#pragma unroll
            for (int j = 0; j < 8; ++j) { v[j] = __builtin_nontemporal_load(xr + 64 * j); s += (v[j][0] * v[j][0] + v[j][1] * v[j][1]) + (v[j][2] * v[j][2] + v[j][3] * v[j][3]); }
            const float rs = rsqrtf(wave_sum(s) * (1.f / DM) + 1e-6f);
            unsigned long long* o8 = (unsigned long long*)(XN + (size_t)m * DM) + lane;
#pragma unroll
            for (int j = 0; j < 8; ++j) { const f32x4 g = ((const f32x4*)abn_)[lane + 64 * j];
                o8[64 * j] = (unsigned long long)pk2(v[j][0] * rs * g[0], v[j][1] * rs * g[1]) | ((unsigned long long)pk2(v[j][2] * rs * g[2], v[j][3] * rs * g[3]) << 32); }
        }
        __syncthreads();
    }
    SEAM(0); STAMP(1);
    if (IN(1)) { unsigned char* const ws = WSLOAD(); PH_IDS();
        pg8::Gemm g{XN, WtIn, M, NIN, DM}; pg8::StaticOrder S; S.init(M, NIN, G, bx);
        for (int rep_ = 0; rep_ < REPN(1); ++rep_) { pg8::EpiProj E{PROJ, rep_ ? nullptr : vsum, vsq, ws + WS_KVIMG};
        pg8::gemm_phase<pg8::EpiProj, pg8::StaticOrder, true, true>((LAS unsigned char*)lds, g, S, E); }
    }
    SEAM(1); STAMP(2);
    if (IN(2)) { unsigned char* const ws = WSLOAD(); PH_IDS();
        float lam;
        { const float a0 = K_ab_lambda[lane] * K_ab_lambda[128 + lane] + K_ab_lambda[64 + lane] * K_ab_lambda[192 + lane];
          const float a1 = K_ab_lambda[256 + lane] * K_ab_lambda[384 + lane] + K_ab_lambda[320 + lane] * K_ab_lambda[448 + lane];
          lam = __uint_as_float(__builtin_amdgcn_readfirstlane(__float_as_uint(__expf(wave_sum(a0)) - __expf(wave_sum(a1)) + 0.2f))); }
#ifndef NO_ATT
        { unsigned* actr = (unsigned*)(ws + WS_ACTR); volatile LAS unsigned* slotw = (volatile LAS unsigned*)((LAS unsigned char*)lds + LDS_BYTES - 32);
          const unsigned xcc = xb_xcc_id() & 7u;
          for (unsigned qi = 0; qi < 8u; ++qi) { const unsigned xq = (xcc + qi) & 7u;
            for (;;) {
              if (threadIdx.x == 0) slotw[0] = __hip_atomic_fetch_add(actr + 16 * xq, 1u, __ATOMIC_RELAXED, __HIP_MEMORY_SCOPE_AGENT);
              __syncthreads(); const unsigned slot = slotw[0]; __syncthreads();
              if (slot >= 64u) break;
              const int bh = (int)((slot >> 5) * 8u + xq), s = (int)(slot & 31u);
#pragma unroll 1
              for (int k = 0; k < 2; ++k) att::attn_unit2(bh >> 3, bh & 7, k ? s : 63 - s, k != 0, ws + WS_KVIMG, (const att::bf16*)PROJ, (att::bf16*)YMIX, lam, K_ab_head_norm, (char*)lds);
            } } }
#endif
#ifndef NO_SGU
        for (int u = vcu; u < 512 * REPN(2); u += G) att::sgu_unit((u & 511) >> 3, u & 7, (const att::bf16*)PROJ, (att::bf16*)YMIX, (const att::bf16*)Wsb, vsum, vsq, K_sgu_ln_g, K_sgu_ln_b, K_sgu_b, (char*)lds);
#endif
    }
    SEAM(2); STAMP(3);
    if (IN(3)) { unsigned char* const ws = WSLOAD(); PH_IDS();
        pg8::Gemm g{YMIX, WtOut, M, DM, NMIX}; pg8::StaticOrder S; S.init(M, DM, G, bx);
        for (int rep_ = 0; rep_ < REPN(3); ++rep_) { pg8::EpiRes<true> E{K_x, K_out, X1B, rep_ ? nullptr : ss1};
        pg8::gemm_phase<pg8::EpiRes<true>, pg8::StaticOrder, true, true>((LAS unsigned char*)lds, g, S, E); }
    }
    SEAM(3); STAMP(4);
    for (int rep_ = 0; rep_ < REPN(4); ++rep_) if (IN(4)) { unsigned char* const ws = WSLOAD(); PH_IDS();
        pg8::Gemm g{X1B, WtCin, M, NCIN, DM}; pg8::StaticOrder S; S.init(M, NCIN, G, bx);
        pg8::EpiProj2 E{PROJ2, ss1};
        pg8::gemm_phase<pg8::EpiProj2, pg8::StaticOrder, true, true>((LAS unsigned char*)lds, g, S, E);
        if (G == 256 && bx >= 160) {
            __syncthreads();
            float* scr = (float*)(lds + wave * 16384); const int gw2 = (bx - 160) * NWAVES + wave, NGW2 = 96 * NWAVES, gt2 = (bx - 160) * 512 + tid, NGT2 = 96 * 512;
            p0_transpose_matrix(K_c_w_out, CW, DM, WtCout, nullptr, scr, lane, gw2, NGW2);
            const float* gaw = K_c_gate_a_w; const float* gxw = K_c_gate_x_w;
            for (int i = gt2; i < 16 * 2 * 192 * 192; i += NGT2) { const int ii = i % 192, j = (i / 192) % 192, gate = (i / (192 * 192)) & 1, hd = i / (2 * 192 * 192);
                float v = 0.f; if (ii < 168 && j < 168) v = (gate ? gxw : gaw)[((size_t)hd * 168 + ii) * 168 + j];
                WgT[i] = (bf16)f2bf(v); }
        }
    }
    SEAM(4); STAMP(5);
    for (int rep_ = 0; rep_ < REPN(5); ++rep_) if (IN(5)) { unsigned char* const ws = WSLOAD(); PH_IDS();
        for (int u0 = vcu * 8; u0 < 2048; u0 += G * 8) { const int bh = u0 >> 6, tc0 = u0 & 63;
            lru_group(bh >> 4, bh & 15, tc0, kap, ws, (char*)lds); }
    }
    STAMP(6);
    if (false) { unsigned char* const ws = WSLOAD(); PH_IDS();
        for (int u = vcu; u < 256; u += G) carry_unit(u, HL, PP, PROJ2, sumA, sumH, YMIX2, (char*)lds);
    }
    SEAM(6); STAMP(7);
    if (IN(7)) { unsigned char* const ws = WSLOAD(); PH_IDS();
        pg8::Gemm g{YMIX2, WtCout, M, DM, CW}; pg8::StaticOrder S; S.init(M, DM, G, bx);
        if (G == 256) { pg8::EpiFinal E{K_out, K_out, ss2, (unsigned*)(ws + WS_PCNT), K_final_norm};
            pg8::gemm_phase<pg8::EpiFinal, pg8::StaticOrder, true, true>((LAS unsigned char*)lds, g, S, E); }
        else { pg8::EpiRes<false> E{K_out, K_out, nullptr, ss2};
            pg8::gemm_phase<pg8::EpiRes<false>, pg8::StaticOrder, true, true>((LAS unsigned char*)lds, g, S, E); }
    }
    if (G != 256) { SEAM(7); } STAMP(8);
    for (int rep_ = 0; rep_ < REPN(8); ++rep_) if (IN(8) && G != 256) { unsigned char* const ws = WSLOAD(); PH_IDS();
        for (int m = gw; m < M; m += NGW) { f32x4* xr = (f32x4*)(K_out + (size_t)m * DM) + lane; const float rs = rsqrtf(ss2[m] * (1.f / DM) + 1e-6f);
#pragma unroll
            for (int j = 0; j < 8; ++j) { const f32x4 g = ((const f32x4*)K_final_norm)[lane + 64 * j]; f32x4 v = xr[64 * j]; v = v * rs * g; xr[64 * j] = v; } }
    }
#ifdef TPROBE_A
    if (bx == 0 && threadIdx.x == 0) { STAMP(9); asm volatile("s_waitcnt vmcnt(0) lgkmcnt(0)" ::: "memory");
        K_out[0] = (float)(tsl[TPROBE_A + 1] - tsl[TPROBE_A]) * 0.01f; K_out[1] = (float)(tsl[TPROBE_B + 1] - tsl[TPROBE_B]) * 0.01f; }
#endif
#undef IN
#undef SEAM
}

extern "C" void kernel_launch(void* const* d_in, const int* in_sizes, int n_in, void* d_out, int out_size, void* d_ws, size_t ws_size, hipStream_t stream) {
    static int grid = 0;
    if (grid == 0) {
        if (n_in != 21 || out_size != M * DM || ws_size < WS_END) { fprintf(stderr, "kernel_launch: unexpected shapes (n_in %d out %d ws %zu)\n", n_in, out_size, ws_size); grid = -1; return; }
        int dev = 0, cus = 0, per_cu = 0;
        (void)hipGetDevice(&dev); (void)hipDeviceGetAttribute(&cus, hipDeviceAttributeMultiprocessorCount, dev);
        if (hipFuncSetAttribute((const void*)mk_fwd, hipFuncAttributeMaxDynamicSharedMemorySize, LDS_BYTES) != hipSuccess) { fprintf(stderr, "kernel_launch: hipFuncSetAttribute failed\n"); grid = -1; return; }
        (void)hipOccupancyMaxActiveBlocksPerMultiprocessor(&per_cu, (const void*)mk_fwd, NWAVES * 64, LDS_BYTES);
        (void)hipGetLastError();
        if (per_cu < 1) { fprintf(stderr, "kernel_launch: occupancy query says %d blocks per CU\n", per_cu); per_cu = 1; }
        grid = cus;
    }
    if (grid < 0) return;
    Args a{};
    for (int i = 0; i < 21; ++i) a.in[i] = (const float*)d_in[i];
    a.out = (float*)d_out; a.ws = (unsigned char*)d_ws;
#if MK_N_LAUNCHES == 1
    a.ph_lo = 0; a.ph_hi = 9;
    (void)hipMemsetAsync((char*)d_ws + WS_BAR, 0, 65536, stream);
    void* kargs[] = {&a};
    hipError_t e = hipLaunchCooperativeKernel((const void*)mk_fwd, dim3(grid), dim3(NWAVES * 64), kargs, LDS_BYTES, stream);
    if (e != hipSuccess) fprintf(stderr, "kernel_launch: cooperative launch failed: %s (grid %d)\n", hipGetErrorString(e), grid);
#else
    for (int p = 0; p < 9; ++p) { a.ph_lo = p; a.ph_hi = p + 1; hipLaunchKernelGGL(mk_fwd, dim3(grid), dim3(NWAVES * 64), LDS_BYTES, stream, a); }
#endif
}
```

```cpp
#include <hip/hip_runtime.h>
#include <hip/hip_cooperative_groups.h>
#include <hip/hip_bf16.h>
#include <cstdio>
#include <cstdint>
#include <cmath>
namespace cg = cooperative_groups;
#ifndef MK_N_LAUNCHES
#define MK_N_LAUNCHES 1
#endif
namespace pg8 {
#define PG8_LAS __attribute__((address_space(3)))
typedef unsigned short bf16_t;
typedef short bf16x8 __attribute__((ext_vector_type(8)));
typedef float f32x4 __attribute__((ext_vector_type(4)));
typedef unsigned u32x4 __attribute__((ext_vector_type(4)));
constexpr int BM = 256, BK = 64, HALF = 128, HTB = HALF * BK * 2  , STAGE_BYTES = 8 * HTB, NXCD = 8, WGM = 8;

__host__ __device__ __forceinline__ int lds_byte(int r, int c) { const int st = (r >> 4) * 2 + (c >> 5), rr = r & 15, cc = c & 31, ob = rr * 64 + cc * 2; return st * 1024 + (ob ^ (((ob >> 9) & 1) << 5)); }
__host__ __device__ __forceinline__ void stage_rc(int b, int& R, int& C) { const int st = b / 1024, sb = b % 1024, swz = sb ^ (((sb >> 9) & 1) << 5); R = (st >> 1) * 16 + swz / 64; C = (st & 1) * 32 + (swz % 64) / 2; }
__host__ __device__ __forceinline__ int perm32(int rho) { const int n = rho >> 4, i = rho & 15; return 8 * (i >> 2) + 4 * n + (i & 3); }

struct Unit { int pm, pn; };
struct Gemm { const bf16_t* A; const bf16_t* Bt; int M, N, K; };

struct StaticOrder {
    int nM, nN, nwg, G, c;
    __host__ __device__ void init(int M, int N, int G_, int c_) { nM = M / BM; nN = N / BM; nwg = nM * nN; G = G_; c = c_; }
    __host__ __device__ bool next(int i, Unit& u) const {
        const long L = (long)i * G + c; if (L >= nwg) return false;
        int wgid = (int)L; { const int q = nwg / NXCD, r = nwg % NXCD, xcd = wgid % NXCD, off = wgid / NXCD; wgid = (xcd < r ? xcd * (q + 1) : r * (q + 1) + (xcd - r) * q) + off; }
        const int nig = WGM * nN, gid = wgid / nig, fm = gid * WGM, gsz = (nM - fm) < WGM ? (nM - fm) : WGM;
        u.pm = fm + ((wgid % nig) % gsz); u.pn = (wgid % nig) / gsz; return true;
    }
    __device__ __forceinline__ void a_ready(const Unit&) const {}
    __device__ __forceinline__ void done(const Unit&) const {}
};

__device__ __forceinline__ unsigned cvt_pk_bf16(float lo, float hi) { unsigned r; asm volatile("v_cvt_pk_bf16_f32 %0, %1, %2" : "=v"(r) : "v"(lo), "v"(hi)); return r; }
typedef float f32x2 __attribute__((ext_vector_type(2)));
typedef unsigned u32x2 __attribute__((ext_vector_type(2)));
__device__ __forceinline__ float silu_f(float v) { return v * __builtin_amdgcn_rcpf(1.f + __builtin_amdgcn_exp2f(-1.4426950408889634f * v)); }
__device__ __forceinline__ float gelu_tanh_f(float v) { const float u = v * (2.302208198f + 0.1029432397f * v * v); return v * __builtin_amdgcn_rcpf(1.f + __builtin_amdgcn_exp2f(-u)); }
__device__ __forceinline__ float sigmoid_f(float v) { return 1.f / (1.f + __expf(-v)); }

struct EpiProj {
    static constexpr bool PERM = true, AFTER_DRAIN = false;
    bf16_t* O; float* vsum; float* vsq; unsigned char* kvimg;
    __device__ __forceinline__ void operator()(const f32x4 (&acc)[2][2][4][2], const Unit& u, int wr, int wc, int fr, int fq) const {
        const int seg = u.pn >> 3;
        const int row0 = u.pm * BM + wr * 64 + fr, col0 = u.pn * BM + wc * 32 + 8 * fq;
        float t1[2][4], t2[2][4];
#pragma unroll
        for (int ai = 0; ai < 2; ++ai)
#pragma unroll
            for (int m = 0; m < 4; ++m) { const int row = row0 + ai * HALF + m * 16; bf16_t* rowp = O + (size_t)row * 14336 + col0; float s1 = 0.f, s2 = 0.f;
#pragma unroll
                for (int bj = 0; bj < 2; ++bj) { f32x4 v0 = acc[ai][bj][m][0], v1 = acc[ai][bj][m][1];
                    if (seg == 3 || seg == 6) {
#pragma unroll
                        for (int e = 0; e < 4; ++e) { v0[e] = silu_f(v0[e]); v1[e] = silu_f(v1[e]); }
                    } else if (seg == 4 || seg == 5) {
#pragma unroll
                        for (int e = 0; e < 4; ++e) { v0[e] = gelu_tanh_f(v0[e]); v1[e] = gelu_tanh_f(v1[e]); }
                        if (seg == 5) {
#pragma unroll
                            for (int e = 0; e < 4; ++e) { s1 += v0[e] + v1[e]; s2 += v0[e] * v0[e] + v1[e] * v1[e]; } }
                    }
                    u32x4 w; w.x = cvt_pk_bf16(v0[0], v0[1]); w.y = cvt_pk_bf16(v0[2], v0[3]); w.z = cvt_pk_bf16(v1[0], v1[1]); w.w = cvt_pk_bf16(v1[2], v1[3]);
                    if (seg == 1 || seg == 2) {
                        const int bb = row >> 12, key = row & 4095, tt = key >> 6, k = key & 63, hh = u.pn & 7, c = wc * 32 + 8 * fq;
                        unsigned off;
                        if (seg == 1) off = (unsigned)(bj * 16384 + k * 256 + ((c * 2) ^ ((k & 7) << 4)));
                        else { const int kk = (k & ~0xC) | ((k & 4) << 1) | ((k & 8) >> 1); off = (unsigned)(32768 + bj * 16384 + ((kk >> 3) * 4 + (c >> 5)) * 512 + ((kk & 7) * 32 + (c & 31)) * 2); }
                        *(u32x4*)(kvimg + ((size_t)((bb * 8 + hh) * 64 + tt) << 16) + off) = w;
                    } else *(u32x4*)(rowp + bj * HALF) = w; }
                if (seg == 5 && vsum) { s1 += __shfl_xor(s1, 16); s1 += __shfl_xor(s1, 32); s2 += __shfl_xor(s2, 16); s2 += __shfl_xor(s2, 32); t1[ai][m] = s1; t2[ai][m] = s2; } }
        if (seg == 5 && vsum) {
#pragma unroll
            for (int ai = 0; ai < 2; ++ai) { const int r64 = u.pm * BM + wr * 64 + ai * HALF + fq * 16 + fr;
                const float a1 = fq == 0 ? t1[ai][0] : fq == 1 ? t1[ai][1] : fq == 2 ? t1[ai][2] : t1[ai][3], a2 = fq == 0 ? t2[ai][0] : fq == 1 ? t2[ai][1] : fq == 2 ? t2[ai][2] : t2[ai][3];
                atomicAdd(vsum + r64, a1); atomicAdd(vsq + r64, a2); } }
    }
};
template <bool WB> struct EpiRes {
    static constexpr bool PERM = false, AFTER_DRAIN = false;
    const float* base; float* out; bf16_t* ob; float* ss;
    __device__ __forceinline__ void operator()(const f32x4 (&acc)[2][2][4][2], const Unit& u, int wr, int wc, int fr, int fq) const {
        const int row0 = u.pm * BM + wr * 64 + fr, col0 = u.pn * BM + wc * 32 + 4 * fq;
        float ts[2][4];
#pragma unroll
        for (int ai = 0; ai < 2; ++ai)
#pragma unroll
            for (int m = 0; m < 4; ++m) { const int row = row0 + ai * HALF + m * 16; const size_t off = (size_t)row * 2048 + col0; float s = 0.f;
#pragma unroll
                for (int bj = 0; bj < 2; ++bj)
#pragma unroll
                    for (int n = 0; n < 2; ++n) { const size_t o2 = off + bj * HALF + n * 16; const f32x4 b = __builtin_nontemporal_load((const f32x4*)(base + o2)); const f32x4 o = b + acc[ai][bj][m][n];
                        *(f32x4*)(out + o2) = o; s += (o[0] * o[0] + o[1] * o[1]) + (o[2] * o[2] + o[3] * o[3]);
                        if (WB) { u32x2 w; w.x = cvt_pk_bf16(o[0], o[1]); w.y = cvt_pk_bf16(o[2], o[3]); *(u32x2*)(ob + o2) = w; } }
                s += __shfl_xor(s, 16); s += __shfl_xor(s, 32); ts[ai][m] = s; }
        if (ss) {
#pragma unroll
            for (int ai = 0; ai < 2; ++ai) { const float a = fq == 0 ? ts[ai][0] : fq == 1 ? ts[ai][1] : fq == 2 ? ts[ai][2] : ts[ai][3];
                atomicAdd(ss + u.pm * BM + wr * 64 + ai * HALF + fq * 16 + fr, a); } }
    }
};
struct EpiProj2 {
    static constexpr bool PERM = true, AFTER_DRAIN = false;
    bf16_t* O; const float* ss;
    __device__ __forceinline__ void operator()(const f32x4 (&acc)[2][2][4][2], const Unit& u, int wr, int wc, int fr, int fq) const {
        const int row0 = u.pm * BM + wr * 64 + fr, colt = u.pn * BM, col0 = colt + wc * 32 + 8 * fq;
#pragma unroll
        for (int ai = 0; ai < 2; ++ai)
#pragma unroll
            for (int m = 0; m < 4; ++m) { const int row = row0 + ai * HALF + m * 16; bf16_t* rowp = O + (size_t)row * 5376 + col0;
                const float rs = rsqrtf(ss[row] * (1.f / 2048.f) + 1e-6f);
#pragma unroll
                for (int bj = 0; bj < 2; ++bj) { f32x4 v0 = acc[ai][bj][m][0] * rs, v1 = acc[ai][bj][m][1] * rs;
                    if (colt + bj * HALF >= 2688) {
#pragma unroll
                        for (int e = 0; e < 4; ++e) { v0[e] = silu_f(v0[e]); v1[e] = silu_f(v1[e]); } }
                    u32x4 w; w.x = cvt_pk_bf16(v0[0], v0[1]); w.y = cvt_pk_bf16(v0[2], v0[3]); w.z = cvt_pk_bf16(v1[0], v1[1]); w.w = cvt_pk_bf16(v1[2], v1[3]);
                    *(u32x4*)(rowp + bj * HALF) = w; } }
    }
};
struct EpiFinal {
    static constexpr bool PERM = false, AFTER_DRAIN = true;
    const float* base; float* out; float* ss; unsigned* cnt; const float* g;
    __device__ __forceinline__ void fused(f32x4 (&acc)[2][2][4][2], const Unit& u, int wr, int wc, int fr, int fq, PG8_LAS unsigned char* lds, int wid, int lane) const {
        const int row0 = u.pm * BM + wr * 64 + fr, col0 = u.pn * BM + wc * 32 + 4 * fq;
        float ts[2][4];
#pragma unroll
        for (int ai = 0; ai < 2; ++ai)
#pragma unroll
            for (int m = 0; m < 4; ++m) { const int row = row0 + ai * HALF + m * 16; const size_t off = (size_t)row * 2048 + col0; float s = 0.f;
#pragma unroll
                for (int bj = 0; bj < 2; ++bj)
#pragma unroll
                    for (int n = 0; n < 2; ++n) { const f32x4 b = __builtin_nontemporal_load((const f32x4*)(base + off + bj * HALF + n * 16)); const f32x4 o = b + acc[ai][bj][m][n]; acc[ai][bj][m][n] = o;
                        s += (o[0] * o[0] + o[1] * o[1]) + (o[2] * o[2] + o[3] * o[3]); }
                s += __shfl_xor(s, 16); s += __shfl_xor(s, 32); ts[ai][m] = s;
                if (m & 1) asm volatile("" ::: "memory"); }
#pragma unroll
        for (int ai = 0; ai < 2; ++ai) { const float a = fq == 0 ? ts[ai][0] : fq == 1 ? ts[ai][1] : fq == 2 ? ts[ai][2] : ts[ai][3];
            __hip_atomic_fetch_add(ss + u.pm * BM + wr * 64 + ai * HALF + fq * 16 + fr, a, __ATOMIC_RELAXED, __HIP_MEMORY_SCOPE_AGENT); }
        asm volatile("s_waitcnt vmcnt(0)" ::: "memory");
        unsigned* c = cnt + 64 * u.pm;
        if (lane == 0) __hip_atomic_fetch_add(c, 1u, __ATOMIC_RELAXED, __HIP_MEMORY_SCOPE_AGENT);
        { unsigned sp = 0; while (__hip_atomic_load(c, __ATOMIC_RELAXED, __HIP_MEMORY_SCOPE_AGENT) < 64u) { __builtin_amdgcn_s_sleep(2); if (++sp > (1u << 22)) break; } }
        __builtin_amdgcn_fence(__ATOMIC_ACQUIRE, "agent");
#pragma unroll
        for (int ai = 0; ai < 2; ++ai)
#pragma unroll
            for (int m = 0; m < 4; ++m) { const int row = row0 + ai * HALF + m * 16; const size_t off = (size_t)row * 2048 + col0;
                const float rs = rsqrtf(__hip_atomic_load(ss + row, __ATOMIC_RELAXED, __HIP_MEMORY_SCOPE_AGENT) * (1.f / 2048.f) + 1e-6f);
#pragma unroll
                for (int bj = 0; bj < 2; ++bj)
#pragma unroll
                    for (int n = 0; n < 2; ++n) { const f32x4 gv = *(const f32x4*)(g + col0 + bj * HALF + n * 16); __builtin_nontemporal_store(acc[ai][bj][m][n] * rs * gv, (f32x4*)(out + off + bj * HALF + n * 16)); } }
    }
};
template <class Epi, class Sched, bool ALIGN_EPI = false, bool SP2 = false>
__device__ __forceinline__ void gemm_phase(PG8_LAS unsigned char* lds, const Gemm g, const Sched& S, const Epi& E) {
    int tid_ = threadIdx.x; asm volatile("" : "+v"(tid_)); const int tid = tid_, wid = __builtin_amdgcn_readfirstlane(tid >> 6), lane = tid & 63, wr = wid >> 2, wc = wid & 3, fr = lane & 15, fq = lane >> 4;
    const int K = g.K, nt = K / BK;
    unsigned voffA[2], voffB[2];
#pragma unroll
    for (int i = 0; i < 2; ++i) { int R, C; stage_rc(tid * 16 + i * 8192, R, C); const int Rb = Epi::PERM ? ((R & ~31) + perm32(R & 31)) : R;
        voffA[i] = (unsigned)(R * K + C) * 2u; voffB[i] = (unsigned)(Rb * K + C) * 2u; }
    const size_t kstep = (size_t)(BK * 2);
    const size_t hstep = (size_t)HALF * K * 2;
    const size_t tstep = 2 * hstep;
    const unsigned ldsw = (unsigned)wid * 1024u;
    const int aoff = lds_byte(wr * 64 + fr, fq * 8), boff = lds_byte(wc * 32 + fr, fq * 8);
#define PG8_SA(b, h) (((b) * 2 + (h)) * HTB)
#define PG8_SB(b, h) ((4 + (b) * 2 + (h)) * HTB)
#define PG8_STAGE(bufoff, gbase, voff) do { _Pragma("unroll") for (int _i = 0; _i < 2; ++_i) \
        __builtin_amdgcn_global_load_lds((const unsigned*)((const char*)(gbase) + (voff)[_i]), (PG8_LAS unsigned*)(lds + (bufoff) + ldsw + _i * 8192), 16, 0, 0); } while (0)
#define PG8_LDA(dst, b, h) do { _Pragma("unroll") for (int m = 0; m < 4; ++m) _Pragma("unroll") for (int k = 0; k < 2; ++k) dst[m][k] = *(const PG8_LAS bf16x8*)(lds + PG8_SA(b, h) + aoff + m * 2048 + k * 1024); } while (0)
#define PG8_LDB(dst, b, h) do { _Pragma("unroll") for (int n = 0; n < 2; ++n) _Pragma("unroll") for (int k = 0; k < 2; ++k) dst[n][k] = *(const PG8_LAS bf16x8*)(lds + PG8_SB(b, h) + boff + n * 2048 + k * 1024); } while (0)
#define PG8_MMA(ai, bj, At, Bt) do { __builtin_amdgcn_s_setprio(1); _Pragma("unroll") for (int m = 0; m < 4; ++m) _Pragma("unroll") for (int n = 0; n < 2; ++n) _Pragma("unroll") for (int k = 0; k < 2; ++k) \
        acc[ai][bj][m][n] = __builtin_amdgcn_mfma_f32_16x16x32_bf16(Bt[n][k], At[m][k], acc[ai][bj][m][n], 0, 0, 0); __builtin_amdgcn_s_setprio(0); } while (0)
#define PG8_WAIT_V(n) asm volatile("s_waitcnt vmcnt(" #n ")" ::: "memory")
#define PG8_WAIT_L(n) asm volatile("s_waitcnt lgkmcnt(" #n ")" ::: "memory")
#define PG8_BAR __builtin_amdgcn_s_barrier()
#define PG8_SCHED __builtin_amdgcn_sched_barrier(0)
    Unit cur, nxt; int ui = 0;
    if (!S.next(0, cur)) return;
    f32x4 acc[2][2][4][2];
#pragma unroll
    for (int a = 0; a < 2; ++a)
#pragma unroll
        for (int b = 0; b < 2; ++b)
#pragma unroll
            for (int m = 0; m < 4; ++m)
#pragma unroll
                for (int n = 0; n < 2; ++n) acc[a][b][m][n] = (f32x4){0.f, 0.f, 0.f, 0.f};
    bf16x8 At[4][2], B0[2][2], B1[2][2];
    const char* cA = (const char*)g.A + (size_t)cur.pm * tstep; const char* cB = (const char*)g.Bt + (size_t)cur.pn * tstep;
    S.a_ready(cur);
    if constexpr (SP2) {
        PG8_STAGE(PG8_SB(0, 0), cB, voffB); PG8_STAGE(PG8_SB(0, 1), cB + hstep, voffB); PG8_STAGE(PG8_SA(0, 0), cA, voffA); PG8_STAGE(PG8_SA(0, 1), cA + hstep, voffA);
        if (wr == 1) PG8_BAR;
        PG8_WAIT_V(2); PG8_BAR;
        PG8_STAGE(PG8_SB(1, 0), cB + kstep, voffB); PG8_STAGE(PG8_SA(1, 0), cA + kstep, voffA); PG8_STAGE(PG8_SB(1, 1), cB + hstep + kstep, voffB);
        PG8_WAIT_V(6); PG8_BAR;
    } else {
        PG8_STAGE(PG8_SB(0, 0), cB, voffB); PG8_STAGE(PG8_SA(0, 0), cA, voffA); PG8_STAGE(PG8_SB(0, 1), cB + hstep, voffB); PG8_STAGE(PG8_SA(0, 1), cA + hstep, voffA);
        if (wr == 1) PG8_BAR;
        PG8_WAIT_V(4); PG8_BAR;
        PG8_STAGE(PG8_SB(1, 0), cB + kstep, voffB); PG8_STAGE(PG8_SA(1, 0), cA + kstep, voffA); PG8_STAGE(PG8_SB(1, 1), cB + hstep + kstep, voffB);
        PG8_WAIT_V(6); PG8_BAR;
    }
    for (;;) {
        const bool has_next = S.next(ui + 1, nxt);
        const char* nA = has_next ? (const char*)g.A + (size_t)nxt.pm * tstep : cA; const char* nB = has_next ? (const char*)g.Bt + (size_t)nxt.pn * tstep : cB;
        for (int t = 0; t < nt; t += 2) {
            const bool last = (t == nt - 2);
            const char* a1 = cA + (size_t)(t + 1) * kstep;
            const char* a2 = last ? nA : cA + (size_t)(t + 2) * kstep; const char* b2 = last ? nB : cB + (size_t)(t + 2) * kstep;
            const char* a3 = a2 + kstep; const char* b3 = b2 + kstep;
            if (last && has_next) S.a_ready(nxt);
            if constexpr (SP2) {
            PG8_LDB(B0, 0, 0); PG8_LDB(B1, 0, 1); PG8_SCHED; PG8_LDA(At, 0, 0); PG8_STAGE(PG8_SA(1, 1), a1 + hstep, voffA);
            PG8_WAIT_V(8); PG8_WAIT_L(0); PG8_BAR; PG8_MMA(0, 0, At, B0); PG8_MMA(0, 1, At, B1); PG8_BAR; PG8_SCHED;
            PG8_LDA(At, 0, 1); PG8_STAGE(PG8_SB(0, 0), b2, voffB); PG8_STAGE(PG8_SB(0, 1), b2 + hstep, voffB); PG8_STAGE(PG8_SA(0, 0), a2, voffA);
            PG8_WAIT_V(8); PG8_WAIT_L(0); PG8_BAR; PG8_MMA(1, 0, At, B0); PG8_MMA(1, 1, At, B1); PG8_BAR; PG8_SCHED;
            PG8_LDB(B0, 1, 0); PG8_LDB(B1, 1, 1); PG8_SCHED; PG8_LDA(At, 1, 0); PG8_STAGE(PG8_SA(0, 1), a2 + hstep, voffA);
            PG8_WAIT_V(8); PG8_WAIT_L(0); PG8_BAR; PG8_MMA(0, 0, At, B0); PG8_MMA(0, 1, At, B1); PG8_BAR; PG8_SCHED;
            PG8_LDA(At, 1, 1); PG8_STAGE(PG8_SB(1, 0), b3, voffB); PG8_STAGE(PG8_SB(1, 1), b3 + hstep, voffB); PG8_STAGE(PG8_SA(1, 0), a3, voffA);
            PG8_WAIT_V(8); PG8_WAIT_L(0); PG8_BAR; PG8_MMA(1, 0, At, B0); PG8_MMA(1, 1, At, B1); PG8_BAR; PG8_SCHED;
            } else {
            PG8_LDB(B0, 0, 0); PG8_SCHED; PG8_LDA(At, 0, 0); PG8_STAGE(PG8_SA(1, 1), a1 + hstep, voffA);
            PG8_WAIT_L(8); PG8_BAR; PG8_WAIT_L(0); PG8_MMA(0, 0, At, B0); PG8_BAR; PG8_SCHED;
            PG8_LDB(B1, 0, 1); PG8_STAGE(PG8_SB(0, 0), b2, voffB);
            PG8_BAR; PG8_WAIT_L(0); PG8_MMA(0, 1, At, B1); PG8_BAR;
            PG8_LDA(At, 0, 1); PG8_STAGE(PG8_SA(0, 0), a2, voffA);
            PG8_BAR; PG8_WAIT_L(0); PG8_MMA(1, 0, At, B0); PG8_BAR; PG8_SCHED;
            PG8_STAGE(PG8_SB(0, 1), b2 + hstep, voffB);
            PG8_WAIT_V(6); PG8_BAR; PG8_MMA(1, 1, At, B1); PG8_BAR;
            PG8_LDB(B0, 1, 0); PG8_SCHED; PG8_LDA(At, 1, 0); PG8_STAGE(PG8_SA(0, 1), a2 + hstep, voffA);
            PG8_WAIT_L(8); PG8_BAR; PG8_WAIT_L(0); PG8_MMA(0, 0, At, B0); PG8_BAR; PG8_SCHED;
            PG8_LDB(B1, 1, 1); PG8_STAGE(PG8_SB(1, 0), b3, voffB);
            PG8_BAR; PG8_WAIT_L(0); PG8_MMA(0, 1, At, B1); PG8_BAR;
            PG8_LDA(At, 1, 1); PG8_STAGE(PG8_SA(1, 0), a3, voffA);
            PG8_BAR; PG8_WAIT_L(0); PG8_MMA(1, 0, At, B0); PG8_BAR; PG8_SCHED;
            PG8_STAGE(PG8_SB(1, 1), b3 + hstep, voffB);
            PG8_WAIT_V(6); PG8_BAR; PG8_MMA(1, 1, At, B1); PG8_BAR;
            }
        }
        if constexpr (ALIGN_EPI) { if (wr == 0) PG8_BAR; }
        if constexpr (!Epi::AFTER_DRAIN) { E(acc, cur, wr, wc, fr, fq); S.done(cur); }
        if (!has_next) break;
#pragma unroll
        for (int a = 0; a < 2; ++a)
#pragma unroll
            for (int b = 0; b < 2; ++b)
#pragma unroll
                for (int m = 0; m < 4; ++m)
#pragma unroll
                    for (int n = 0; n < 2; ++n) acc[a][b][m][n] = (f32x4){0.f, 0.f, 0.f, 0.f};
        cur = nxt; cA = nA; cB = nB; ++ui;
        if constexpr (ALIGN_EPI) { if (wr == 1) PG8_BAR; }
    }
    PG8_WAIT_V(0);
    if constexpr (!ALIGN_EPI) { if (wr == 0) PG8_BAR; }
    PG8_BAR;
    if constexpr (Epi::AFTER_DRAIN) { E.fused(acc, cur, wr, wc, fr, fq, lds, wid, lane); S.done(cur); }
#undef PG8_SA
#undef PG8_SB
#undef PG8_STAGE
#undef PG8_LDA
#undef PG8_LDB
#undef PG8_MMA
#undef PG8_WAIT_V
#undef PG8_WAIT_L
#undef PG8_BAR
#undef PG8_SCHED
}
}

#ifndef PG8_SP2
#define PG8_SP2 true
#endif
namespace att {
using bf16 = __hip_bfloat16;
using bf16x8 = __attribute__((ext_vector_type(8))) short;
using s16x4  = __attribute__((ext_vector_type(4))) short;
using f32x16 = __attribute__((ext_vector_type(16))) float;
using f32x4  = __attribute__((ext_vector_type(4))) float;
using u32x4  = __attribute__((ext_vector_type(4))) unsigned;
using u32x2  = __attribute__((ext_vector_type(2))) unsigned;
constexpr float SCALE = 0.088388347648318440f;
constexpr float THR = 8.f;
constexpr int LDP = 14336;
constexpr int SUB = 16384, BUFB = 4 * SUB, ATT_WS = 2 * BUFB;
#define KSWZ(row, colB) ((row) * 256 + ((colB) ^ (((row) & 7) << 4)))
#define SBAR() __builtin_amdgcn_sched_barrier(0)
__device__ __forceinline__ int crow(int r, int hi) { return (r & 3) + 8 * (r >> 2) + 4 * hi; }
__device__ __forceinline__ unsigned cvtpk(float lo, float hi) {
  unsigned r; asm volatile("v_cvt_pk_bf16_f32 %0, %1, %2" : "=v"(r) : "v"(lo), "v"(hi)); return r;
}
__device__ __forceinline__ void partialSM(f32x16& p0, f32x16& p1, float& m_reg, float& mn, float& alpha) {
  constexpr float C = SCALE * 1.4426950408889634f;
  float pmax = p0[0]; for (int r = 1; r < 16; ++r) pmax = fmaxf(pmax, p0[r]); for (int r = 0; r < 16; ++r) pmax = fmaxf(pmax, p1[r]);
  { auto rr = __builtin_amdgcn_permlane32_swap(__float_as_uint(pmax), __float_as_uint(pmax), false, false);
    pmax = fmaxf(__uint_as_float(rr[0]), __uint_as_float(rr[1])); }
  if (__builtin_expect(__all(pmax - m_reg <= THR / SCALE), 1)) { mn = m_reg; alpha = 1.f; }
  else { mn = fmaxf(m_reg, pmax); alpha = __builtin_amdgcn_exp2f((m_reg - mn) * C); m_reg = mn; }
  float mnC = -mn * C;
  for (int r = 0; r < 16; ++r) p0[r] = fmaf(p0[r], C, mnC); for (int r = 0; r < 16; ++r) p1[r] = fmaf(p1[r], C, mnC);
  for (int r = 0; r < 16; ++r) p0[r] = __builtin_amdgcn_exp2f(p0[r]);
}
__device__ __forceinline__ void finishSM(f32x16& p0, f32x16& p1, float alpha, float& l_reg, bf16x8& pa0, bf16x8& pa1, bf16x8& pa2, bf16x8& pa3) {
  for (int r = 0; r < 16; ++r) p1[r] = __builtin_amdgcn_exp2f(p1[r]);
  float ps = 0; for (int r = 0; r < 16; ++r) ps += p0[r]; for (int r = 0; r < 16; ++r) ps += p1[r];
  { auto rr = __builtin_amdgcn_permlane32_swap(__float_as_uint(ps), __float_as_uint(ps), false, false);
    ps = __uint_as_float(rr[0]) + __uint_as_float(rr[1]); }
  l_reg = l_reg * alpha + ps;
#define PK4(P, BASE, OUT) do { unsigned a0 = cvtpk(P[BASE + 0], P[BASE + 1]), a1 = cvtpk(P[BASE + 2], P[BASE + 3]);   \
    unsigned b0 = cvtpk(P[BASE + 4], P[BASE + 5]), b1 = cvtpk(P[BASE + 6], P[BASE + 7]);                              \
    auto r0 = __builtin_amdgcn_permlane32_swap(a0, b0, false, false); auto r1 = __builtin_amdgcn_permlane32_swap(a1, b1, false, false); \
    u32x4 w = {r0[0], r1[0], r0[1], r1[1]}; OUT = *reinterpret_cast<bf16x8*>(&w); } while (0)
  PK4(p0, 0, pa0); PK4(p0, 8, pa1); PK4(p1, 0, pa2); PK4(p1, 8, pa3);
#undef PK4
}
__device__ __forceinline__ void qkt(f32x16& p0, f32x16& p1, const bf16* Ks, const bf16x8* qr, int r32, int hi) {
  p0 = f32x16{}; p1 = f32x16{};
  for (int d0 = 0; d0 < 8; ++d0) { int cb = (d0 * 16 + hi * 8) * 2;
    bf16x8 b0 = *reinterpret_cast<const bf16x8*>((const char*)Ks + KSWZ(r32, cb));
    bf16x8 b1 = *reinterpret_cast<const bf16x8*>((const char*)Ks + KSWZ(32 + r32, cb));
    p0 = __builtin_amdgcn_mfma_f32_32x32x16_bf16(b0, qr[d0], p0, 0, 0, 0);
    p1 = __builtin_amdgcn_mfma_f32_32x32x16_bf16(b1, qr[d0], p1, 0, 0, 0); }
}
__device__ __forceinline__ int v_st(int k, int c) { const int kk = (k & ~0xC) | ((k & 4) << 1) | ((k & 8) >> 1); return ((kk >> 3) * 4 + (c >> 5)) * 512 + ((kk & 7) * 32 + (c & 31)) * 2; }
__device__ __forceinline__ int v_rd_base(int lane) { return ((lane & 3) << 3) | (((lane >> 2) & 3) << 6) | (((lane >> 4) & 1) << 5) | (((lane >> 5) & 1) << 8); }
constexpr int v_rd_off(int d0, int ks, int half) { return d0 * 512 + ks * 4096 + half * 2048; }
template <int OFF> __device__ __forceinline__ s16x4 tr_read(int vb) {
  s16x4 r; asm volatile("ds_read_b64_tr_b16 %0, %1 offset:%2" : "=&v"(r) : "v"(vb), "i"(OFF) : "memory"); return r;
}
template <int D0> __device__ __forceinline__ void pv_one(f32x16& od, int vb, bf16x8 pa0, bf16x8 pa1, bf16x8 pa2, bf16x8 pa3) {
  const s16x4 l0 = tr_read<v_rd_off(D0, 0, 0)>(vb), h0 = tr_read<v_rd_off(D0, 0, 1)>(vb), l1 = tr_read<v_rd_off(D0, 1, 0)>(vb), h1 = tr_read<v_rd_off(D0, 1, 1)>(vb);
  const s16x4 l2 = tr_read<v_rd_off(D0, 2, 0)>(vb), h2 = tr_read<v_rd_off(D0, 2, 1)>(vb), l3 = tr_read<v_rd_off(D0, 3, 0)>(vb), h3 = tr_read<v_rd_off(D0, 3, 1)>(vb);
  asm volatile("s_waitcnt lgkmcnt(0)" ::: "memory"); SBAR();
#define PK(L, H) (bf16x8){L[0], L[1], L[2], L[3], H[0], H[1], H[2], H[3]}
  od = __builtin_amdgcn_mfma_f32_32x32x16_bf16(pa0, PK(l0, h0), od, 0, 0, 0);
  od = __builtin_amdgcn_mfma_f32_32x32x16_bf16(pa1, PK(l1, h1), od, 0, 0, 0);
  od = __builtin_amdgcn_mfma_f32_32x32x16_bf16(pa2, PK(l2, h2), od, 0, 0, 0);
  od = __builtin_amdgcn_mfma_f32_32x32x16_bf16(pa3, PK(l3, h3), od, 0, 0, 0);
#undef PK
}
__device__ __forceinline__ void pv_d0(f32x16* o, int vb, bf16x8 pa0, bf16x8 pa1, bf16x8 pa2, bf16x8 pa3) {
  pv_one<0>(o[0], vb, pa0, pa1, pa2, pa3); pv_one<1>(o[1], vb, pa0, pa1, pa2, pa3); pv_one<2>(o[2], vb, pa0, pa1, pa2, pa3); pv_one<3>(o[3], vb, pa0, pa1, pa2, pa3);
}
__device__ __forceinline__ float bf2f(unsigned short s) { return __uint_as_float((unsigned)s << 16); }
__device__ __forceinline__ float wave_sum(float v) {
#pragma unroll
  for (int o = 1; o < 64; o <<= 1) v += __shfl_xor(v, o);
  return v;
}
__device__ __forceinline__ void attn_unit(int b, int h, int qc, const bf16* __restrict__ proj, bf16* __restrict__ ymix, float lam, const float* __restrict__ hnorm, char* lds) {
  int tid_ = threadIdx.x; asm volatile("" : "+v"(tid_)); const int tid = tid_, wid = __builtin_amdgcn_readfirstlane(tid >> 6), lane = tid & 63, r32 = lane & 31, hi = lane >> 5;
  asm volatile("" : "+s"(b), "+s"(h), "+s"(proj), "+s"(ymix), "+s"(hnorm));
  proj = (const bf16*)(const __attribute__((address_space(1))) bf16*)(uintptr_t)proj; ymix = (bf16*)(__attribute__((address_space(1))) bf16*)(uintptr_t)ymix;
  hnorm = (const float*)(const __attribute__((address_space(1))) float*)(uintptr_t)hnorm;
  const int rg = wid & 1, map = (wid >> 1) & 1, vh = wid >> 2;
  float* ws = (float*)(lds + ATT_WS) + wid * 64; float* li_l = ws; float* al_l = ws + 32;
  const long rowbase = (long)b * 4096;
  const bf16* Kg = proj + rowbase * LDP + 2048 + h * 256;
  const bf16* Vg = proj + rowbase * LDP + 4096 + h * 256;
  const bf16* Qw = proj + (rowbase + qc * 64 + rg * 32 + r32) * LDP + h * 256 + map * 128 + hi * 8;
  float m_reg = -1e30f, l_reg = 0; f32x16 o[4] = {}; bf16x8 qr[8];
#pragma unroll
  for (int d0 = 0; d0 < 8; ++d0) qr[d0] = *reinterpret_cast<const bf16x8*>(Qw + d0 * 16);
  const int sr = tid >> 4, sc = (tid & 15) * 8, vst0 = v_st(sr, sc), vst1 = v_st(32 + sr, sc), kst0 = KSWZ(sr, sc * 2), kst1 = KSWZ(32 + sr, sc * 2);
  const int vb0 = (int)(uintptr_t)lds + 2 * SUB + vh * SUB + v_rd_base(lane);
  const bf16* Kt0 = (const bf16*)(lds + map * SUB); const bf16* Kt1 = (const bf16*)(lds + BUFB + map * SUB);
  bf16x8 s0, s1, s2, s3;
#define SLOADK(k0) do { const bf16* kp = Kg + (long)((k0) + sr) * LDP + sc; \
    s0 = *(const bf16x8*)kp; s1 = *(const bf16x8*)(kp + 32L * LDP); s2 = *(const bf16x8*)(kp + 128); s3 = *(const bf16x8*)(kp + 32L * LDP + 128); } while (0)
#define SLOADV(k0) do { const bf16* vp = Vg + (long)((k0) + sr) * LDP + sc; \
    s0 = *(const bf16x8*)vp; s1 = *(const bf16x8*)(vp + 32L * LDP); s2 = *(const bf16x8*)(vp + 128); s3 = *(const bf16x8*)(vp + 32L * LDP + 128); } while (0)
#define SWRITEK(bf) do { char* bb = lds + (bf) * BUFB; *(bf16x8*)(bb + kst0) = s0; *(bf16x8*)(bb + kst1) = s1; *(bf16x8*)(bb + SUB + kst0) = s2; *(bf16x8*)(bb + SUB + kst1) = s3; } while (0)
#define SWRITEV(bf) do { char* bb = lds + (bf) * BUFB + 2 * SUB; *(bf16x8*)(bb + vst0) = s0; *(bf16x8*)(bb + vst1) = s1; *(bf16x8*)(bb + SUB + vst0) = s2; *(bf16x8*)(bb + SUB + vst1) = s3; } while (0)
#define SWAIT() asm volatile("s_waitcnt vmcnt(0)" ::: "memory")
#define RESC(a) do { if (__any((a) < 1.f)) { if (hi == 0) al_l[r32] = (a); asm volatile("s_waitcnt lgkmcnt(0)" ::: "memory"); \
    for (int d = 0; d < 4; ++d) for (int r = 0; r < 16; ++r) o[d][r] *= al_l[crow(r, hi)]; } } while (0)
  f32x16 pA0, pA1, pB0, pB1; float mnA, mnB, alA, alB; bf16x8 pa0, pa1, pa2, pa3; const int NT = qc + 1;
  SLOADK(0); SWAIT(); SWRITEK(0); SLOADV(0); SWAIT(); SWRITEV(0); __syncthreads();
  if (NT > 1) SLOADK(64);
  qkt(pA0, pA1, Kt0, qr, r32, hi); partialSM(pA0, pA1, m_reg, mnA, alA);
  if (NT > 1) { SWAIT(); SWRITEK(1); SLOADV(64); SWAIT(); SWRITEV(1); }
  __syncthreads();
  int j = 1;
  for (; j + 1 < NT; j += 2) {
    SLOADK((j + 1) * 64);
    SBAR(); qkt(pB0, pB1, Kt1, qr, r32, hi);
    finishSM(pA0, pA1, alA, l_reg, pa0, pa1, pa2, pa3); SBAR();
    SWAIT(); SWRITEK(0); SLOADV((j + 1) * 64); SBAR();
    pv_d0(o, vb0, pa0, pa1, pa2, pa3); partialSM(pB0, pB1, m_reg, mnB, alB);
    __syncthreads(); SWAIT(); SWRITEV(0);
    RESC(alB); __syncthreads();
    const bool more = (j + 2 < NT);
    if (more) SLOADK((j + 2) * 64);
    SBAR(); qkt(pA0, pA1, Kt0, qr, r32, hi);
    finishSM(pB0, pB1, alB, l_reg, pa0, pa1, pa2, pa3); SBAR();
    if (more) { SWAIT(); SWRITEK(1); SLOADV((j + 2) * 64); } SBAR();
    pv_d0(o, vb0 + BUFB, pa0, pa1, pa2, pa3); partialSM(pA0, pA1, m_reg, mnA, alA);
    __syncthreads(); if (more) { SWAIT(); SWRITEV(1); }
    RESC(alA); __syncthreads();
  }
  if (j < NT) {
    SBAR(); qkt(pB0, pB1, Kt1, qr, r32, hi);
    finishSM(pA0, pA1, alA, l_reg, pa0, pa1, pa2, pa3); SBAR();
    pv_d0(o, vb0, pa0, pa1, pa2, pa3); partialSM(pB0, pB1, m_reg, mnB, alB);
    __syncthreads(); RESC(alB);
    finishSM(pB0, pB1, alB, l_reg, pa0, pa1, pa2, pa3); SBAR();
    pv_d0(o, vb0 + BUFB, pa0, pa1, pa2, pa3);
  } else {
    finishSM(pA0, pA1, alA, l_reg, pa0, pa1, pa2, pa3); SBAR();
    pv_d0(o, vb0, pa0, pa1, pa2, pa3);
  }
  if (hi == 0) li_l[r32] = l_reg;
  __syncthreads();
  { float* Ob = (float*)lds + wid * 4096;
#pragma unroll
    for (int r = 0; r < 16; ++r) { const int orow = crow(r, hi);
#pragma unroll
      for (int d0 = 0; d0 < 4; ++d0) Ob[orow * 128 + d0 * 32 + r32] = o[d0][r]; } }
  __syncthreads();
  const float* lall = (const float*)(lds + ATT_WS);
#pragma unroll 1
  for (int rr = 0; rr < 8; ++rr) {
    const int row = wid * 8 + rr, rg2 = row >> 5, r5 = row & 31, c = lane * 4, vh2 = c >> 7, cc = c & 127, w1 = rg2 + 4 * vh2;
    const float* O1 = (const float*)lds + w1 * 4096 + r5 * 128 + cc;
    const float il1 = 1.f / lall[w1 * 64 + r5], il2 = lam / lall[(w1 + 2) * 64 + r5];
    const f32x4 a = *(const f32x4*)O1 * il1, b2 = *(const f32x4*)(O1 + 2 * 4096) * il2;
    const f32x4 d = a - b2;
    const float ssq = wave_sum((d[0] * d[0] + d[1] * d[1]) + (d[2] * d[2] + d[3] * d[3]));
    const float rstd = rsqrtf(ssq * (1.f / 256.f) + 1e-6f) * 0.8f;
    const f32x4 g = *(const f32x4*)(hnorm + h * 256 + c);
    const long grow = rowbase + qc * 64 + row;
    const u32x2 zz = *(const u32x2*)(proj + grow * LDP + 6144 + h * 256 + c);
    const float z0 = __uint_as_float(zz.x << 16), z1 = __uint_as_float(zz.x & 0xffff0000u), z2 = __uint_as_float(zz.y << 16), z3 = __uint_as_float(zz.y & 0xffff0000u);
    u32x2 w; w.x = cvtpk(d[0] * rstd * g[0] * z0, d[1] * rstd * g[1] * z1); w.y = cvtpk(d[2] * rstd * g[2] * z2, d[3] * rstd * g[3] * z3);
    *(u32x2*)(ymix + grow * 4096 + h * 256 + c) = w;
  }
  __syncthreads();
#undef SLOADK
#undef SLOADV
#undef SWRITEK
#undef SWRITEV
#undef SWAIT
#undef RESC
}
template <int D0> __device__ __forceinline__ void pv_pair(f32x16& oa, f32x16& ob, int vb, bf16x8 pa0, bf16x8 pa1) {
  const s16x4 l0 = tr_read<v_rd_off(D0, 0, 0)>(vb), h0 = tr_read<v_rd_off(D0, 0, 1)>(vb), l1 = tr_read<v_rd_off(D0, 1, 0)>(vb), h1 = tr_read<v_rd_off(D0, 1, 1)>(vb);
  const s16x4 l2 = tr_read<v_rd_off(D0 + 1, 0, 0)>(vb), h2 = tr_read<v_rd_off(D0 + 1, 0, 1)>(vb), l3 = tr_read<v_rd_off(D0 + 1, 1, 0)>(vb), h3 = tr_read<v_rd_off(D0 + 1, 1, 1)>(vb);
  asm volatile("s_waitcnt lgkmcnt(0)" ::: "memory"); SBAR();
#define PK(L, H) (bf16x8){L[0], L[1], L[2], L[3], H[0], H[1], H[2], H[3]}
  oa = __builtin_amdgcn_mfma_f32_32x32x16_bf16(pa0, PK(l0, h0), oa, 0, 0, 0);
  ob = __builtin_amdgcn_mfma_f32_32x32x16_bf16(pa0, PK(l2, h2), ob, 0, 0, 0);
  oa = __builtin_amdgcn_mfma_f32_32x32x16_bf16(pa1, PK(l1, h1), oa, 0, 0, 0);
  ob = __builtin_amdgcn_mfma_f32_32x32x16_bf16(pa1, PK(l3, h3), ob, 0, 0, 0);
#undef PK
}
__device__ __forceinline__ void attn_unit2(int b, int h, int qc, bool rev, const unsigned char* kvimg, const bf16* __restrict__ proj, bf16* __restrict__ ymix, float lam, const float* __restrict__ hnorm, char* lds) {
  int tid_ = threadIdx.x; asm volatile("" : "+v"(tid_)); const int tid = tid_, wid = __builtin_amdgcn_readfirstlane(tid >> 6), lane = tid & 63, r32 = lane & 31, hi = lane >> 5;
  asm volatile("" : "+s"(b), "+s"(h), "+s"(proj), "+s"(ymix), "+s"(hnorm));
  proj = (const bf16*)(const __attribute__((address_space(1))) bf16*)(uintptr_t)proj; ymix = (bf16*)(__attribute__((address_space(1))) bf16*)(uintptr_t)ymix;
  hnorm = (const float*)(const __attribute__((address_space(1))) float*)(uintptr_t)hnorm;
  const int rg = wid & 1, map = (wid >> 1) & 1, kh = wid >> 2;
  float* ws = (float*)(lds + ATT_WS) + wid * 64; float* li_l = ws; float* al_l = ws + 32;
  const long rowbase = (long)b * 4096;
  const bf16* Qw = proj + (rowbase + qc * 64 + rg * 32 + r32) * LDP + h * 256 + map * 128 + hi * 8;
  bf16x8 qr[8];
#pragma unroll
  for (int d0 = 0; d0 < 8; ++d0) qr[d0] = *reinterpret_cast<const bf16x8*>(Qw + d0 * 16);
  __attribute__((address_space(3))) char* lds3 = (__attribute__((address_space(3))) char*)(unsigned)(uintptr_t)lds;
  asm volatile("" : "+s"(kvimg));
  const __attribute__((address_space(1))) char* imgu = (const __attribute__((address_space(1))) char*)(uintptr_t)kvimg + ((size_t)((b * 8 + h) * 64) << 16) + (wid >> 2) * SUB + (wid & 3) * 4096;
  const unsigned voff = (unsigned)lane * 16u;
  typedef __attribute__((address_space(3))) unsigned las_u32; typedef __attribute__((address_space(1))) const unsigned gas_u32;
#define DMAK_(t_, bf) do { gas_u32* kb_ = (gas_u32*)(imgu + ((size_t)(t_) << 16) + voff); las_u32* ldk_ = (las_u32*)(lds3 + (bf) * BUFB + (wid >> 2) * SUB + (wid & 3) * 4096); \
    __builtin_amdgcn_global_load_lds(kb_, ldk_, 16, 0, 0); __builtin_amdgcn_global_load_lds(kb_, ldk_, 16, 1024, 0); __builtin_amdgcn_global_load_lds(kb_, ldk_, 16, 2048, 0); __builtin_amdgcn_global_load_lds(kb_, ldk_, 16, 3072, 0); } while (0)
#define DMAV_(t_, bf) do { gas_u32* vb_ = (gas_u32*)(imgu + ((size_t)(t_) << 16) + 2 * SUB + voff); las_u32* ldv_ = (las_u32*)(lds3 + (bf) * BUFB + 2 * SUB + (wid >> 2) * SUB + (wid & 3) * 4096); \
    __builtin_amdgcn_global_load_lds(vb_, ldv_, 16, 0, 0); __builtin_amdgcn_global_load_lds(vb_, ldv_, 16, 1024, 0); __builtin_amdgcn_global_load_lds(vb_, ldv_, 16, 2048, 0); __builtin_amdgcn_global_load_lds(vb_, ldv_, 16, 3072, 0); } while (0)
#define DMAKV(t_, bf) do { DMAK_(t_, bf); DMAV_(t_, bf); } while (0)
  const int krow = 32 * kh + r32;
  const int vbk = (int)(uintptr_t)lds + 2 * SUB + kh * 8192 + v_rd_base(lane);
  float m_reg = -1e30f, l_reg = 0.f; f32x16 o[8] = {};
  constexpr float C = SCALE * 1.4426950408889634f;
  const int NT = qc + 1;
  DMAKV((rev ? NT - 1 : 0), 0); __syncthreads();
  for (int j = 0; j < NT; ++j) {
    const int bo = (j & 1) * BUFB;
    const int kn = (rev ? NT - 2 - j : j + 1);
    if (j + 1 < NT) DMAV_(kn, (j + 1) & 1);
    f32x16 p = {}; const char* Kb = lds + bo + map * SUB;
    { bf16x8 kf[8];
#pragma unroll
      for (int d0 = 0; d0 < 4; ++d0) kf[d0] = *reinterpret_cast<const bf16x8*>(Kb + KSWZ(krow, (d0 * 16 + hi * 8) * 2));
      SBAR();
#pragma unroll
      for (int d0 = 4; d0 < 8; ++d0) kf[d0] = *reinterpret_cast<const bf16x8*>(Kb + KSWZ(krow, (d0 * 16 + hi * 8) * 2));
#pragma unroll
      for (int d0 = 0; d0 < 8; ++d0) p = __builtin_amdgcn_mfma_f32_32x32x16_bf16(kf[d0], qr[d0], p, 0, 0, 0); }
    SBAR();
    if (j + 1 < NT) DMAK_(kn, (j + 1) & 1);
    SBAR();
    float pmax = p[0];
#pragma unroll
    for (int r = 1; r < 16; ++r) pmax = fmaxf(pmax, p[r]);
    { auto rr = __builtin_amdgcn_permlane32_swap(__float_as_uint(pmax), __float_as_uint(pmax), false, false); pmax = fmaxf(__uint_as_float(rr[0]), __uint_as_float(rr[1])); }
    float mn, alpha;
    if (__builtin_expect(__all(pmax - m_reg <= THR / SCALE), 1)) { mn = m_reg; alpha = 1.f; }
    else { mn = fmaxf(m_reg, pmax); alpha = __builtin_amdgcn_exp2f((m_reg - mn) * C); m_reg = mn; }
    const float mnC = -mn * C; float ps = 0.f;
#pragma unroll
    for (int r = 0; r < 16; ++r) { p[r] = __builtin_amdgcn_exp2f(fmaf(p[r], C, mnC)); ps += p[r]; }
    { auto rr = __builtin_amdgcn_permlane32_swap(__float_as_uint(ps), __float_as_uint(ps), false, false); ps = __uint_as_float(rr[0]) + __uint_as_float(rr[1]); }
    l_reg = l_reg * alpha + ps;
    if (__any(alpha < 1.f)) { if (hi == 0) al_l[r32] = alpha; asm volatile("s_waitcnt lgkmcnt(0)" ::: "memory");
#pragma unroll
      for (int d = 0; d < 8; ++d)
#pragma unroll
        for (int r = 0; r < 16; ++r) o[d][r] *= al_l[crow(r, hi)]; }
    bf16x8 pa0, pa1;
#define PK4(P, BASE, OUT) do { unsigned a0 = cvtpk(P[BASE + 0], P[BASE + 1]), a1 = cvtpk(P[BASE + 2], P[BASE + 3]);   \
    unsigned b0 = cvtpk(P[BASE + 4], P[BASE + 5]), b1 = cvtpk(P[BASE + 6], P[BASE + 7]);                              \
    auto r0 = __builtin_amdgcn_permlane32_swap(a0, b0, false, false); auto r1 = __builtin_amdgcn_permlane32_swap(a1, b1, false, false); \
    u32x4 w = {r0[0], r1[0], r0[1], r1[1]}; OUT = *reinterpret_cast<bf16x8*>(&w); } while (0)
    PK4(p, 0, pa0); PK4(p, 8, pa1);
#undef PK4
    SBAR();
    const int vb = vbk + bo;
    {
#define PVRD(D0, VB, A) const s16x4 A##l0 = tr_read<v_rd_off(D0, 0, 0)>(VB), A##h0 = tr_read<v_rd_off(D0, 0, 1)>(VB), A##l1 = tr_read<v_rd_off(D0, 1, 0)>(VB), A##h1 = tr_read<v_rd_off(D0, 1, 1)>(VB), \
      A##l2 = tr_read<v_rd_off(D0 + 1, 0, 0)>(VB), A##h2 = tr_read<v_rd_off(D0 + 1, 0, 1)>(VB), A##l3 = tr_read<v_rd_off(D0 + 1, 1, 0)>(VB), A##h3 = tr_read<v_rd_off(D0 + 1, 1, 1)>(VB)
#define PK(L, H) (bf16x8){L[0], L[1], L[2], L[3], H[0], H[1], H[2], H[3]}
#define PVMM(OA, OB, A) do { OA = __builtin_amdgcn_mfma_f32_32x32x16_bf16(pa0, PK(A##l0, A##h0), OA, 0, 0, 0); OB = __builtin_amdgcn_mfma_f32_32x32x16_bf16(pa0, PK(A##l2, A##h2), OB, 0, 0, 0); \
      OA = __builtin_amdgcn_mfma_f32_32x32x16_bf16(pa1, PK(A##l1, A##h1), OA, 0, 0, 0); OB = __builtin_amdgcn_mfma_f32_32x32x16_bf16(pa1, PK(A##l3, A##h3), OB, 0, 0, 0); } while (0)
      const int vb2 = vb + SUB;
      PVRD(0, vb, A); PVRD(2, vb, B);
      asm volatile("s_waitcnt lgkmcnt(8)" ::: "memory"); SBAR(); PVMM(o[0], o[1], A); SBAR();
      PVRD(0, vb2, C);
      asm volatile("s_waitcnt lgkmcnt(8)" ::: "memory"); SBAR(); PVMM(o[2], o[3], B); SBAR();
      PVRD(2, vb2, D);
      asm volatile("s_waitcnt lgkmcnt(8)" ::: "memory"); SBAR(); PVMM(o[4], o[5], C); SBAR();
      asm volatile("s_waitcnt lgkmcnt(0)" ::: "memory"); SBAR(); PVMM(o[6], o[7], D);
#undef PVRD
#undef PK
#undef PVMM
    }
    __syncthreads();
  }
  if (hi == 0) { li_l[r32] = l_reg; al_l[r32] = m_reg; }
  __syncthreads();
  const float* sall = (const float*)(lds + ATT_WS);
  { const int wp = wid ^ 4;
    float fs[16];
#pragma unroll
    for (int r = 0; r < 16; ++r) { const int q = crow(r, hi);
      const float m0 = sall[wid * 64 + 32 + q], m1 = sall[wp * 64 + 32 + q], l0 = sall[wid * 64 + q], l1 = sall[wp * 64 + q];
      const float mm = fmaxf(m0, m1), f0 = __builtin_amdgcn_exp2f((m0 - mm) * C), f1 = __builtin_amdgcn_exp2f((m1 - mm) * C);
      fs[r] = f0 * __builtin_amdgcn_rcpf(l0 * f0 + l1 * f1) * (map ? -lam : 1.f); }
    unsigned short* Ob = (unsigned short*)lds + wid * 8192;
#pragma unroll
    for (int r = 0; r < 16; ++r) { const int orow = crow(r, hi);
#pragma unroll
      for (int d0 = 0; d0 < 8; ++d0) Ob[orow * 256 + d0 * 32 + r32] = (unsigned short)(cvtpk(o[d0][r] * fs[r], 0.f) & 0xffffu); } }
  __syncthreads();
#pragma unroll 2
  for (int rr = 0; rr < 8; ++rr) {
    const int row = wid * 8 + rr, rg2 = row >> 5, r5 = row & 31, c4 = lane * 4;
    float e0 = 0.f, e1 = 0.f, e2 = 0.f, e3 = 0.f;
#pragma unroll
    for (int ww = 0; ww < 4; ++ww) { const u32x2 v = *(const u32x2*)((const unsigned short*)lds + (rg2 + 2 * ww) * 8192 + r5 * 256 + c4);
      e0 += __uint_as_float(v.x << 16); e1 += __uint_as_float(v.x & 0xffff0000u); e2 += __uint_as_float(v.y << 16); e3 += __uint_as_float(v.y & 0xffff0000u); }
    const float ssq = wave_sum((e0 * e0 + e1 * e1) + (e2 * e2 + e3 * e3)); const float rstd = rsqrtf(ssq * (1.f / 256.f) + 1e-6f) * 0.8f;
    const long grow = rowbase + qc * 64 + row; const f32x4 g = *(const f32x4*)(hnorm + h * 256 + c4);
    const u32x2 zz = *(const u32x2*)(proj + grow * LDP + 6144 + h * 256 + c4);
    u32x2 w; w.x = cvtpk(e0 * rstd * g[0] * __uint_as_float(zz.x << 16), e1 * rstd * g[1] * __uint_as_float(zz.x & 0xffff0000u));
    w.y = cvtpk(e2 * rstd * g[2] * __uint_as_float(zz.y << 16), e3 * rstd * g[3] * __uint_as_float(zz.y & 0xffff0000u));
    *(u32x2*)(ymix + grow * 4096 + h * 256 + c4) = w; }
  __syncthreads();
#undef DMAKV
#undef DMAK_
#undef DMAV_
}
__device__ __forceinline__ void sgu_unit(int n, int g, const bf16* __restrict__ proj, bf16* __restrict__ ymix, const bf16* __restrict__ Wsb, const float* __restrict__ vsum, const float* __restrict__ vsq,
                                         const float* __restrict__ ln_g, const float* __restrict__ ln_b, const float* __restrict__ b_s, char* lds) {
  int tid_ = threadIdx.x; asm volatile("" : "+v"(tid_)); const int tid = tid_, wid = __builtin_amdgcn_readfirstlane(tid >> 6), lane = tid & 63, r32 = lane & 31, hi = lane >> 5;
  unsigned short* vT = (unsigned short*)lds;
  float* mean_l = (float*)(lds + 256 * 136 * 2); float* rstd_l = mean_l + 128;
  const long t0 = (long)n * 128; const int c0 = g * 256;
  if (tid < 128) { const float m = vsum[t0 + tid] * (1.f / 2048.f); const float var = vsq[t0 + tid] * (1.f / 2048.f) - m * m; mean_l[tid] = m; rstd_l[tid] = rsqrtf(fmaxf(var, 0.f) + 1e-6f); }
  __syncthreads();
#pragma unroll 4
  for (int k = 0; k < 8; ++k) { const int t = (tid & 63) + 64 * (k & 1), c = ((tid >> 6) + 8 * (k >> 1)) * 8;
    const u32x4 raw = *(const u32x4*)(proj + (t0 + t) * LDP + 10240 + c0 + c);
    const f32x4 g0 = *(const f32x4*)(ln_g + c0 + c), g1 = *(const f32x4*)(ln_g + c0 + c + 4), b0 = *(const f32x4*)(ln_b + c0 + c), b1 = *(const f32x4*)(ln_b + c0 + c + 4);
    const float mu = mean_l[t], rs = rstd_l[t];
    float v[8] = {__uint_as_float(raw.x << 16), __uint_as_float(raw.x & 0xffff0000u), __uint_as_float(raw.y << 16), __uint_as_float(raw.y & 0xffff0000u),
                  __uint_as_float(raw.z << 16), __uint_as_float(raw.z & 0xffff0000u), __uint_as_float(raw.w << 16), __uint_as_float(raw.w & 0xffff0000u)};
#pragma unroll
    for (int e = 0; e < 8; ++e) { const float gg = e < 4 ? g0[e & 3] : g1[e & 3], bb = e < 4 ? b0[e & 3] : b1[e & 3];
      const float val = (v[e] - mu) * rs * gg + bb; vT[(c + e) * 136 + t] = (unsigned short)(cvtpk(val, 0.f) & 0xffffu); } }
  __syncthreads();
  u32x4 uu[8], zq[8];
#pragma unroll
  for (int k = 0; k < 8; ++k) { const int item = tid + 512 * k, i = item >> 5, c = (item & 31) * 8; const long row = t0 + i;
    uu[k] = *(const u32x4*)(proj + row * LDP + 8192 + c0 + c); zq[k] = *(const u32x4*)(proj + row * LDP + 12288 + c0 + c); }
  f32x16 acc[4] = {};
#pragma unroll 4
  for (int ks = 0; ks < 8; ++ks) { const bf16x8 B = *(const bf16x8*)(vT + (32 * wid + r32) * 136 + ks * 16 + hi * 8);
#pragma unroll
    for (int m = 0; m < 4; ++m) { const bf16x8 A = *(const bf16x8*)(Wsb + g * 16384 + (32 * m + r32) * 128 + ks * 16 + hi * 8);
      acc[m] = __builtin_amdgcn_mfma_f32_32x32x16_bf16(A, B, acc[m], 0, 0, 0); } }
  __syncthreads();
  unsigned short* mx = (unsigned short*)lds;
#pragma unroll
  for (int m = 0; m < 4; ++m)
#pragma unroll
    for (int r = 0; r < 16; ++r) { const int i = 32 * m + crow(r, hi);
      mx[i * 264 + 32 * wid + r32] = (unsigned short)(cvtpk(acc[m][r] + b_s[g * 128 + i], 0.f) & 0xffffu); }
  __syncthreads();
#pragma unroll 8
  for (int k = 0; k < 8; ++k) { const int item = tid + 512 * k, i = item >> 5, c = (item & 31) * 8; const long row = t0 + i;
    const u32x4 mm = *(const u32x4*)(mx + i * 264 + c); const u32x4 uu_ = uu[k], zz = zq[k];
    u32x4 o;
#define LO(x) __uint_as_float((x) << 16)
#define HI(x) __uint_as_float((x) & 0xffff0000u)
    o.x = cvtpk(LO(uu_.x) * LO(mm.x) * LO(zz.x), HI(uu_.x) * HI(mm.x) * HI(zz.x)); o.y = cvtpk(LO(uu_.y) * LO(mm.y) * LO(zz.y), HI(uu_.y) * HI(mm.y) * HI(zz.y));
    o.z = cvtpk(LO(uu_.z) * LO(mm.z) * LO(zz.z), HI(uu_.z) * HI(mm.z) * HI(zz.z)); o.w = cvtpk(LO(uu_.w) * LO(mm.w) * LO(zz.w), HI(uu_.w) * HI(mm.w) * HI(zz.w));
#undef LO
#undef HI
    *(u32x4*)(ymix + row * 4096 + 2048 + c0 + c) = o; }
  __syncthreads();
}
}
#define LAS __attribute__((address_space(3)))
typedef unsigned short bf16;
typedef unsigned v4u __attribute__((ext_vector_type(4)));
typedef unsigned v2u __attribute__((ext_vector_type(2)));
typedef float f32x4 __attribute__((ext_vector_type(4)));
typedef float f32x16 __attribute__((ext_vector_type(16)));
typedef short bf16x8 __attribute__((ext_vector_type(8)));
constexpr int NWAVES = 8;
constexpr int M = 8192, DM = 2048, SEQ = 4096, NIN = 14336, NMIX = 4096, CW = 2688, NCIN = 5376;
constexpr size_t MiB = 1u << 20;
constexpr size_t WS_STATS = 0;
constexpr size_t WS_SUMA = 1 * MiB, WS_SUMH = 3 * MiB;
constexpr size_t WS_WGT = 5 * MiB;
constexpr size_t WS_WSB = 8 * MiB;
constexpr size_t WS_WTOUT = 9 * MiB;
constexpr size_t WS_WTCIN = 25 * MiB;
constexpr size_t WS_WTCOUT = 46 * MiB;
constexpr size_t WS_WTIN = 57 * MiB;
constexpr size_t WS_XN = 113 * MiB;
constexpr size_t WS_YMIX = 57 * MiB, WS_YMIX2 = 57 * MiB;
constexpr size_t WS_PROJ = 145 * MiB;
constexpr size_t WS_X1B = 145 * MiB;
constexpr size_t WS_PROJ2 = 177 * MiB;
constexpr size_t WS_HL = 261 * MiB, WS_PP = 303 * MiB;
constexpr size_t WS_KVIMG = 369 * MiB;
constexpr size_t WS_END = 433 * MiB;
constexpr int LDS_BYTES = 147456;

__device__ __forceinline__ unsigned f2bf(float f) { unsigned u = __builtin_bit_cast(unsigned, f); return (u + 0x7fffu + ((u >> 16) & 1u)) >> 16; }
__device__ __forceinline__ unsigned pk2(float lo, float hi) { return f2bf(lo) | (f2bf(hi) << 16); }
__device__ __forceinline__ float bf2f(unsigned short s) { return __uint_as_float((unsigned)s << 16); }
__device__ __forceinline__ float wave_sum(float v) {
#pragma unroll
    for (int o = 1; o < 64; o <<= 1) v += __shfl_xor(v, o);
    return v;
}
__device__ __forceinline__ int crow(int r, int hi) { return (r & 3) + 8 * (r >> 2) + 4 * hi; }

__device__ __forceinline__ void p0_tr_load(const float* __restrict__ W, int N, int nblk, int item, int lane, f32x4 (&v)[8]) {
    const int kb = item / nblk, nb = item - kb * nblk; const float* p = W + (size_t)(64 * kb + (lane >> 3)) * N + 32 * nb + (lane & 7) * 4;
#pragma unroll
    for (int i = 0; i < 8; ++i) v[i] = __builtin_nontemporal_load((const f32x4*)(p + (size_t)(8 * i) * N));
}
__device__ __forceinline__ void p0_tr_store(int K, int nblk, bf16* __restrict__ WT, const float* __restrict__ kscale, float* scr, int item, int lane, const f32x4 (&v)[8]) {
    const int kb = item / nblk, nb = item - kb * nblk, k0 = 64 * kb, n0 = 32 * nb;
#pragma unroll
    for (int i = 0; i < 8; ++i) { const int kk = 8 * i + (lane >> 3); const float sc = kscale ? kscale[k0 + kk] : 1.f; float* d = scr + kk * 33 + (lane & 7) * 4;
        d[0] = v[i][0] * sc; d[1] = v[i][1] * sc; d[2] = v[i][2] * sc; d[3] = v[i][3] * sc; }
    asm volatile("s_waitcnt lgkmcnt(0)" ::: "memory");
    const int c = lane & 7;
#pragma unroll
    for (int j = 0; j < 4; ++j) { const int n = (lane >> 3) + 8 * j; const float* s = scr + (8 * c) * 33 + n;
        v4u o; o.x = pk2(s[0 * 33], s[1 * 33]); o.y = pk2(s[2 * 33], s[3 * 33]); o.z = pk2(s[4 * 33], s[5 * 33]); o.w = pk2(s[6 * 33], s[7 * 33]);
        *(v4u*)(WT + (size_t)(n0 + n) * K + k0 + 8 * c) = o; }
    asm volatile("s_waitcnt lgkmcnt(0)" ::: "memory");
}
__device__ __forceinline__ void p0_transpose_matrix(const float* __restrict__ W, int K, int N, bf16* __restrict__ WT, const float* __restrict__ kscale, float* scr, int lane, int first, int stride) {
    const int nblk = N / 32, nitems = (K / 64) * nblk;
    f32x4 va[8], vb[8];
    int it = first;
    if (it < nitems) p0_tr_load(W, N, nblk, it, lane, va);
    while (it < nitems) {
        const int it2 = it + stride;
        if (it2 < nitems) p0_tr_load(W, N, nblk, it2, lane, vb);
        p0_tr_store(K, nblk, WT, kscale, scr, it, lane, va);
        if (it2 >= nitems) break;
        const int it3 = it2 + stride;
        if (it3 < nitems) p0_tr_load(W, N, nblk, it3, lane, va);
        p0_tr_store(K, nblk, WT, kscale, scr, it2, lane, vb);
        it = it3;
    }
}


#define RLX_AGENT __ATOMIC_RELAXED, __HIP_MEMORY_SCOPE_AGENT
#define XB_TMO      128
#define XB_XCNT(j)  (256  + 64 * (j))
#define XB_XSUB(j)  (1280 + 64 * (j))
#define XB_XGEN(j)  (2304 + 64 * (j))
#define XB_TOP      3328
#define XB_TOPGEN   3392
#define XCD_BAR_WORDS 3456
#define XB_SPIN_CAP (1u << 18)

__device__ __forceinline__ unsigned xb_ld(unsigned* p)              { return __hip_atomic_load(p, __ATOMIC_RELAXED, __HIP_MEMORY_SCOPE_AGENT); }
__device__ __forceinline__ unsigned xb_add(unsigned* p, unsigned v) { return __hip_atomic_fetch_add(p, v, __ATOMIC_RELAXED, __HIP_MEMORY_SCOPE_AGENT); }
__device__ __forceinline__ unsigned xb_xcc_id() { return (unsigned)__builtin_amdgcn_s_getreg((3 << 11) | 20) & 0xFu; }
#define XB_SPIN(cond, bar) do { unsigned _sp = 0; while (cond) { __builtin_amdgcn_s_sleep(1); \
    if ((++_sp & 255u) == 0u) { if (xb_ld(&(bar)[XB_TMO])) break; if (_sp > XB_SPIN_CAP) { atomicAdd(&(bar)[XB_TMO], 1u); break; } } } } while (0)

struct XcdBarrier {
    unsigned* bar; unsigned x;
    volatile LAS unsigned* st;
};

__device__ __forceinline__ XcdBarrier xcd_barrier_post(unsigned* bar, volatile LAS unsigned* st) {
    XcdBarrier b; b.bar = bar; b.x = xb_xcc_id(); b.st = st;
    if (threadIdx.x == 0) (void)xb_add(&bar[XB_XCNT(b.x)], 1u);
    return b;
}
__device__ __forceinline__ void xcd_barrier_complete(unsigned* bar, unsigned x, unsigned& nloc, unsigned& nx) {
    const unsigned G = gridDim.x * gridDim.y * gridDim.z;
    unsigned sum, cnt, mine, sp = 0u;
    for (;;) {
        sum = 0u; cnt = 0u; mine = 0u;
#pragma unroll
        for (unsigned j = 0; j < 16; ++j) { const unsigned c = xb_ld(&bar[XB_XCNT(j)]); sum += c; cnt += (c > 0u) ? 1u : 0u; mine = (j == x) ? c : mine; }
        if (sum == G) break;
        __builtin_amdgcn_s_sleep(1);
        if ((++sp & 255u) == 0u) { if (xb_ld(&bar[XB_TMO])) break; if (sp > XB_SPIN_CAP) { atomicAdd(&bar[XB_TMO], 1u); break; } }
    }
    nloc = mine > 0u ? mine : 1u; nx = cnt > 0u ? cnt : 1u;
}

__device__ __forceinline__ void xcd_barrier(const XcdBarrier& b) {
    asm volatile("s_waitcnt vmcnt(0)" ::: "memory");
    __syncthreads();
    if (threadIdx.x == 0) {
        unsigned* bar = b.bar;
        __builtin_amdgcn_s_waitcnt(0);
        unsigned nloc = b.st[0], nx = b.st[1];
        if (nloc == 0u) { xcd_barrier_complete(bar, b.x, nloc, nx); b.st[0] = nloc; b.st[1] = nx; }
        const unsigned old = xb_add(&bar[XB_XSUB(b.x)], 1u);
        const unsigned gen = old / nloc;
        if (old + 1u == (gen + 1u) * nloc) {
            __builtin_amdgcn_fence(__ATOMIC_RELEASE, "agent");
            asm volatile("s_waitcnt vmcnt(0)" ::: "memory");
            const unsigned og = xb_add(&bar[XB_TOP], 1u);
            const unsigned tg = og / nx;
            if (og + 1u == (tg + 1u) * nx) xb_add(&bar[XB_TOPGEN], 1u);
            else XB_SPIN(xb_ld(&bar[XB_TOPGEN]) == tg, bar);
            __builtin_amdgcn_fence(__ATOMIC_ACQUIRE, "agent");
            xb_add(&bar[XB_XGEN(b.x)], 1u);
            asm volatile("s_waitcnt vmcnt(0)" ::: "memory");
        } else {
            XB_SPIN(xb_ld(&bar[XB_XGEN(b.x)]) == gen, bar);
            __builtin_amdgcn_fence(__ATOMIC_ACQUIRE, "agent");
            asm volatile("s_waitcnt vmcnt(0)" ::: "memory");
        }
    }
    __syncthreads();
}

constexpr size_t WS_ACTR = 512 * 1024 + 49152;
constexpr size_t WS_GCNT = 512 * 1024 + 32768;
constexpr size_t WS_PCNT = 512 * 1024 + 16384;
constexpr size_t WS_BAR = 512 * 1024;
struct Args { const float* in[21]; float* out; unsigned char* ws; int ph_lo, ph_hi; };

typedef __attribute__((address_space(4))) const volatile unsigned long long* kaq_t;
#define LK_F(i) ((const float*)(const __attribute__((address_space(1))) float*)(kap[(i)]))
__device__ __forceinline__ void lru_group(int b, int hd, int tc0, kaq_t kap, unsigned char* ws, char* lds) {
    const int grp = (b * 16 + hd) * 8 + (tc0 >> 3), gsub = tc0 >> 3;
    int tid_ = threadIdx.x; asm volatile("" : "+v"(tid_)); const int tid = tid_, wid = __builtin_amdgcn_readfirstlane(tid >> 6), lane = tid & 63, r32 = lane & 31, hi = lane >> 5;
    bf16* xraw = (bf16*)lds;
    bf16* xcb = (bf16*)(lds + 22528);
    float* xcf = (float*)(lds + 48128);
    bf16* hlb = (bf16*)(lds + 91136);
    bf16* ppb = (bf16*)(lds + 112640);
    for (int idx = tid; idx < 64 * 4; idx += 512) *(v4u*)(xcb + (idx >> 2) * 200 + 168 + (idx & 3) * 8) = (v4u){0u, 0u, 0u, 0u};
    float* cwl = (float*)(lds + 134848);
    { const float* cw_ = LK_F(12); const float* cb_ = LK_F(13);
      for (int idx = tid; idx < 5 * 168; idx += 512) { const int k = idx / 168, c = idx - k * 168; cwl[idx] = k < 4 ? cw_[k * CW + hd * 168 + c] : cb_[hd * 168 + c]; } }
    const int j = 32 * wid + r32, jc = j < 168 ? j : 167, Cj = hd * 168 + jc;
    bf16x8 Br[12], Bi[12]; float ba = 0.f, bx = 0.f, sp = 0.f;
    if (wid < 6) { const bf16* wr_ = (const bf16*)(ws + WS_WGT) + ((size_t)(hd * 2 + 0) * 192 + j) * 192 + hi * 8; const bf16* wi_ = wr_ + 192 * 192;
#pragma unroll
        for (int ks = 0; ks < 12; ++ks) { Br[ks] = *(const bf16x8*)(wr_ + ks * 16); Bi[ks] = *(const bf16x8*)(wi_ + ks * 16); }
        ba = -1.4426950408889634f * LK_F(15)[Cj]; bx = -1.4426950408889634f * LK_F(17)[Cj]; sp = -8.f * 1.4426950408889634f * log1pf(__expf(-LK_F(18)[Cj])); }
    float c = 0.f, Q = 1.f;
    v4u hv0, hv1, hv2;
#define HALO_LD(TC) do { const bf16* p2_ = (const bf16*)(ws + WS_PROJ2) + (long)b * SEQ * NCIN + hd * 168; \
        { const int it_ = tid, tr_ = it_ / 21, v_ = it_ - tr_ * 21, tl_ = (TC) * 64 + tr_ - 3; hv0 = (v4u){0u, 0u, 0u, 0u}; if (tl_ >= 0) hv0 = *(const v4u*)(p2_ + (long)tl_ * NCIN + v_ * 8); } \
        { const int it_ = tid + 512, tr_ = it_ / 21, v_ = it_ - tr_ * 21, tl_ = (TC) * 64 + tr_ - 3; hv1 = (v4u){0u, 0u, 0u, 0u}; if (tl_ >= 0) hv1 = *(const v4u*)(p2_ + (long)tl_ * NCIN + v_ * 8); } \
        { const int it_ = tid + 1024, tr_ = it_ / 21, v_ = it_ - tr_ * 21, tl_ = (TC) * 64 + tr_ - 3; hv2 = (v4u){0u, 0u, 0u, 0u}; if (it_ < 67 * 21 && tl_ >= 0) hv2 = *(const v4u*)(p2_ + (long)tl_ * NCIN + v_ * 8); } } while (0)
#define HALO_ST() do { { const int it_ = tid, tr_ = it_ / 21, v_ = it_ - tr_ * 21; *(v4u*)(xraw + tr_ * 168 + v_ * 8) = hv0; } \
        { const int it_ = tid + 512, tr_ = it_ / 21, v_ = it_ - tr_ * 21; *(v4u*)(xraw + tr_ * 168 + v_ * 8) = hv1; } \
        { const int it_ = tid + 1024, tr_ = it_ / 21, v_ = it_ - tr_ * 21; if (it_ < 67 * 21) *(v4u*)(xraw + tr_ * 168 + v_ * 8) = hv2; } } while (0)
    HALO_LD(tc0);
#pragma unroll 1
    for (int ci = 0; ci < 8; ++ci) { const int tc = tc0 + ci; const long row0 = (long)b * SEQ + tc * 64;
        HALO_ST();
        if (ci > 0) { const long rowp = row0 - 64;
            for (int it = tid; it < 64 * 21; it += 512) { const int t = it / 21, v = it - t * 21, C = hd * 168 + v * 8;
                __builtin_nontemporal_store(*(const v4u*)(hlb + t * 168 + v * 8), (v4u*)((bf16*)(ws + WS_HL) + (rowp + t) * CW + C)); __builtin_nontemporal_store(*(const v4u*)(ppb + t * 168 + v * 8), (v4u*)((bf16*)(ws + WS_PP) + (rowp + t) * CW + C)); } }
        __syncthreads();
        if (ci < 7) HALO_LD(tc + 1);
        for (int it = tid; it < 64 * 21; it += 512) { const int t = it / 21, v = it - t * 21;
            f32x4 a0 = *(const f32x4*)(cwl + 4 * 168 + v * 8), a1 = *(const f32x4*)(cwl + 4 * 168 + v * 8 + 4);
#pragma unroll
            for (int k = 0; k < 4; ++k) { const v4u xr = *(const v4u*)(xraw + (t + k) * 168 + v * 8); const f32x4 w0 = *(const f32x4*)(cwl + k * 168 + v * 8), w1 = *(const f32x4*)(cwl + k * 168 + v * 8 + 4);
                a0[0] += w0[0] * __uint_as_float(xr.x << 16); a0[1] += w0[1] * __uint_as_float(xr.x & 0xffff0000u); a0[2] += w0[2] * __uint_as_float(xr.y << 16); a0[3] += w0[3] * __uint_as_float(xr.y & 0xffff0000u);
                a1[0] += w1[0] * __uint_as_float(xr.z << 16); a1[1] += w1[1] * __uint_as_float(xr.z & 0xffff0000u); a1[2] += w1[2] * __uint_as_float(xr.w << 16); a1[3] += w1[3] * __uint_as_float(xr.w & 0xffff0000u); }
            v4u o; o.x = pk2(a0[0], a0[1]); o.y = pk2(a0[2], a0[3]); o.z = pk2(a1[0], a1[1]); o.w = pk2(a1[2], a1[3]);
            *(v4u*)(xcb + t * 200 + v * 8) = o; *(f32x4*)(xcf + t * 168 + v * 8) = a0; *(f32x4*)(xcf + t * 168 + v * 8 + 4) = a1; }
        __syncthreads();
        if (wid < 6) {
#pragma unroll 1
            for (int m = 0; m < 2; ++m) {
                f32x16 accr = {}, acci = {};
#pragma unroll
                for (int ks = 0; ks < 12; ++ks) { const bf16x8 A = *(const bf16x8*)(xcb + (32 * m + r32) * 200 + ks * 16 + hi * 8);
                    accr = __builtin_amdgcn_mfma_f32_32x32x16_bf16(A, Br[ks], accr, 0, 0, 0); acci = __builtin_amdgcn_mfma_f32_32x32x16_bf16(A, Bi[ks], acci, 0, 0, 0); }
#pragma unroll
                for (int q = 0; q < 4; ++q) { float Pe[4], He[4]; float P = 1.f, h = 0.f; const int tb = 32 * m + 8 * q + 4 * hi;
#pragma unroll
                    for (int e = 0; e < 4; ++e) { const int r = 4 * q + e;
                        const float rg = __builtin_amdgcn_rcpf(1.f + __builtin_amdgcn_exp2f(fmaf(accr[r], -1.4426950408889634f, ba))), ig = __builtin_amdgcn_rcpf(1.f + __builtin_amdgcn_exp2f(fmaf(acci[r], -1.4426950408889634f, bx)));
                        const float a = __builtin_amdgcn_exp2f(rg * sp), beta = __builtin_amdgcn_sqrtf(fmaxf(fmaf(-a, a, 1.f), 0.f));
                        const float bt = beta * ig * xcf[(tb + e) * 168 + j];
                        h = a * h + bt; P *= a; Pe[e] = P; He[e] = h; }
                    const float Ap = __shfl_xor(P, 32), Hp = __shfl_xor(h, 32);
                    const float Af = hi ? Ap : P, Hf = hi ? Hp : h, As = hi ? P : Ap, Hs = hi ? h : Hp;
                    const float c1 = Af * c + Hf, Q1 = Af * Q; const float cin = hi ? c1 : c, qin = hi ? Q1 : Q; c = As * c1 + Hs; Q = As * Q1;
                    if (j < 168) {
#pragma unroll
                        for (int e = 0; e < 4; e += 2) { const unsigned hh = pg8::cvt_pk_bf16(fmaf(Pe[e], cin, He[e]), fmaf(Pe[e + 1], cin, He[e + 1])), pq = pg8::cvt_pk_bf16(Pe[e] * qin, Pe[e + 1] * qin);
                            hlb[(tb + e) * 168 + j] = (bf16)(hh & 0xffffu); hlb[(tb + e + 1) * 168 + j] = (bf16)(hh >> 16); ppb[(tb + e) * 168 + j] = (bf16)(pq & 0xffffu); ppb[(tb + e + 1) * 168 + j] = (bf16)(pq >> 16); } }
                }
            }
        }
        __syncthreads();
    }
    { const long rowp = (long)b * SEQ + (tc0 + 7) * 64;
        for (int it = tid; it < 64 * 21; it += 512) { const int t = it / 21, v = it - t * 21, C = hd * 168 + v * 8;
            __builtin_nontemporal_store(*(const v4u*)(hlb + t * 168 + v * 8), (v4u*)((bf16*)(ws + WS_HL) + (rowp + t) * CW + C)); __builtin_nontemporal_store(*(const v4u*)(ppb + t * 168 + v * 8), (v4u*)((bf16*)(ws + WS_PP) + (rowp + t) * CW + C)); } }
    float* carr = (float*)(lds + 134144);
    float* grpA = (float*)(ws + WS_SUMA); float* grpH = (float*)(ws + WS_SUMH); unsigned* gcnt = (unsigned*)(ws + WS_GCNT);
    if (wid < 6) {
        if (hi == 0 && j < 168) { __hip_atomic_store(grpA + (size_t)grp * 168 + j, Q, __ATOMIC_RELAXED, __HIP_MEMORY_SCOPE_AGENT); __hip_atomic_store(grpH + (size_t)grp * 168 + j, c, __ATOMIC_RELAXED, __HIP_MEMORY_SCOPE_AGENT); }
        asm volatile("s_waitcnt vmcnt(0)" ::: "memory");
        if (lane == 0) __hip_atomic_fetch_add(gcnt + 16 * grp, 1u, __ATOMIC_RELAXED, __HIP_MEMORY_SCOPE_AGENT);
        float cy = 0.f;
        { const int g0 = grp - gsub;
          unsigned sp = 0;
          for (;;) { unsigned mn_ = 6u;
#pragma unroll
            for (int k = 0; k < 7; ++k) if (k < gsub) { const unsigned v_ = __hip_atomic_load(gcnt + 16 * (g0 + k), __ATOMIC_RELAXED, __HIP_MEMORY_SCOPE_AGENT); mn_ = v_ < mn_ ? v_ : mn_; }
            if (mn_ >= 6u || ++sp > (1u << 20)) break; __builtin_amdgcn_s_sleep(2); }
          float A2[7], H2[7];
#pragma unroll
          for (int k = 0; k < 7; ++k) { A2[k] = 1.f; H2[k] = 0.f; if (k < gsub) { A2[k] = __hip_atomic_load(grpA + (size_t)(g0 + k) * 168 + jc, __ATOMIC_RELAXED, __HIP_MEMORY_SCOPE_AGENT); H2[k] = __hip_atomic_load(grpH + (size_t)(g0 + k) * 168 + jc, __ATOMIC_RELAXED, __HIP_MEMORY_SCOPE_AGENT); } }
#pragma unroll
          for (int k = 0; k < 7; ++k) cy = A2[k] * cy + H2[k]; }
        if (hi == 0 && j < 168) carr[j] = cy;
    }
    __builtin_amdgcn_fence(__ATOMIC_ACQUIRE, "agent");
    __syncthreads();
    { const long rowg = (long)b * SEQ + tc0 * 64; const bf16* HLp = (const bf16*)(ws + WS_HL); const bf16* PPp = (const bf16*)(ws + WS_PP); const bf16* P2p = (const bf16*)(ws + WS_PROJ2); bf16* Y2 = (bf16*)(ws + WS_YMIX2);
#pragma unroll 7
        for (int it = tid; it < 512 * 21; it += 512) { const int t = it / 21, v = it - t * 21, C = hd * 168 + v * 8; const long row = rowg + t;
            const v4u hl = __builtin_nontemporal_load((const v4u*)(HLp + row * CW + C)), pp = __builtin_nontemporal_load((const v4u*)(PPp + row * CW + C)), sz = __builtin_nontemporal_load((const v4u*)(P2p + row * NCIN + CW + C));
            const f32x4 c0 = *(const f32x4*)(carr + v * 8), c1 = *(const f32x4*)(carr + v * 8 + 4);
            v4u o;
#define LO(x) __uint_as_float((x) << 16)
#define HI(x) __uint_as_float((x) & 0xffff0000u)
            o.x = pk2((LO(hl.x) + LO(pp.x) * c0[0]) * LO(sz.x), (HI(hl.x) + HI(pp.x) * c0[1]) * HI(sz.x));
            o.y = pk2((LO(hl.y) + LO(pp.y) * c0[2]) * LO(sz.y), (HI(hl.y) + HI(pp.y) * c0[3]) * HI(sz.y));
            o.z = pk2((LO(hl.z) + LO(pp.z) * c1[0]) * LO(sz.z), (HI(hl.z) + HI(pp.z) * c1[1]) * HI(sz.z));
            o.w = pk2((LO(hl.w) + LO(pp.w) * c1[2]) * LO(sz.w), (HI(hl.w) + HI(pp.w) * c1[3]) * HI(sz.w));
#undef LO
#undef HI
            *(v4u*)(Y2 + row * CW + C) = o; } }
    __syncthreads();
}
__device__ __forceinline__ void carry_unit(int u, const bf16* __restrict__ HL, const bf16* __restrict__ PP, const bf16* __restrict__ proj2, const float* __restrict__ sumA, const float* __restrict__ sumH,
                                           bf16* __restrict__ ymix2, char* lds) {
    int tid_ = threadIdx.x; asm volatile("" : "+v"(tid_)); const int tid = tid_; const int chunk = u >> 1, half = u & 1, b = chunk >> 6, cbase = half * 1344;
    float* carry = (float*)lds;
    for (int c = tid; c < 1344; c += 512) { const int C = cbase + c; float h = 0.f;
#pragma unroll 8
        for (int cc = b * 64; cc < chunk; ++cc) h = sumA[(size_t)cc * CW + C] * h + sumH[(size_t)cc * CW + C];
        carry[c] = h; }
    __syncthreads();
    for (int it = tid; it < 64 * 168; it += 512) { const int t = it / 168, v = it - t * 168; const long row = (long)chunk * 64 + t; const int C = cbase + v * 8;
        const v4u hl = *(const v4u*)(HL + row * CW + C), pp = *(const v4u*)(PP + row * CW + C), sz = *(const v4u*)(proj2 + row * NCIN + CW + C);
        const f32x4 c0 = *(const f32x4*)(carry + v * 8), c1 = *(const f32x4*)(carry + v * 8 + 4);
        v4u o;
#define LO(x) __uint_as_float((x) << 16)
#define HI(x) __uint_as_float((x) & 0xffff0000u)
        o.x = pk2((LO(hl.x) + LO(pp.x) * c0[0]) * LO(sz.x), (HI(hl.x) + HI(pp.x) * c0[1]) * HI(sz.x));
        o.y = pk2((LO(hl.y) + LO(pp.y) * c0[2]) * LO(sz.y), (HI(hl.y) + HI(pp.y) * c0[3]) * HI(sz.y));
        o.z = pk2((LO(hl.z) + LO(pp.z) * c1[0]) * LO(sz.z), (HI(hl.z) + HI(pp.z) * c1[1]) * HI(sz.z));
        o.w = pk2((LO(hl.w) + LO(pp.w) * c1[2]) * LO(sz.w), (HI(hl.w) + HI(pp.w) * c1[3]) * HI(sz.w));
#undef LO
#undef HI
        *(v4u*)(ymix2 + row * CW + C) = o; }
    __syncthreads();
}

__global__ void __launch_bounds__(NWAVES * 64, 2) mk_fwd(Args args) {
    extern __shared__ __attribute__((aligned(16))) unsigned char lds[];
#define PH_IDS() int tid_ = threadIdx.x; asm volatile("" : "+v"(tid_)); const int tid = tid_, lane = tid & 63, wave = __builtin_amdgcn_readfirstlane(tid >> 6); (void)lane; (void)wave; \
    const int gw = vcu * NWAVES + wave, NGW = G * NWAVES; const int gt = bx * 512 + tid, NGT = G * 512; (void)gw; (void)NGW; (void)gt; (void)NGT;
    const int G = gridDim.x; const int bx = blockIdx.x; const int vcu = (G % 8 == 0) ? (bx % 8) * (G / 8) + bx / 8 : bx;
    typedef const float* cfp; typedef __attribute__((address_space(4))) const volatile unsigned long long* kaq;
    const kaq kap = (kaq)__builtin_amdgcn_kernarg_segment_ptr();
#define GAS1 __attribute__((address_space(1)))
#define KIN(i) ((cfp)(const GAS1 float*)(kap[(i)]))
#define WSLOAD() ((unsigned char*)(GAS1 unsigned char*)(kap[22]))
#define K_x KIN(0)
#define K_ab_norm KIN(1)
#define K_ab_w_in KIN(2)
#define K_ab_lambda KIN(3)
#define K_ab_head_norm KIN(4)
#define K_sgu_ln_g KIN(5)
#define K_sgu_ln_b KIN(6)
#define K_sgu_w KIN(7)
#define K_sgu_b KIN(8)
#define K_ab_w_out KIN(9)
#define K_c_norm KIN(10)
#define K_c_w_in KIN(11)
#define K_c_conv_w KIN(12)
#define K_c_conv_b KIN(13)
#define K_c_gate_a_w KIN(14)
#define K_c_gate_a_b KIN(15)
#define K_c_gate_x_w KIN(16)
#define K_c_gate_x_b KIN(17)
#define K_c_lambda KIN(18)
#define K_c_w_out KIN(19)
#define K_final_norm KIN(20)
#define K_out ((float*)(GAS1 float*)(kap[21]))
#define ss1 ((float*)(ws + WS_STATS))
#define ss2 (ss1 + M)
#define vsum (ss1 + 2 * M)
#define vsq (ss1 + 3 * M)
#define sumA ((float*)(ws + WS_SUMA))
#define sumH ((float*)(ws + WS_SUMH))
#define WgT ((bf16*)(ws + WS_WGT))
#define Wsb ((bf16*)(ws + WS_WSB))
#define WtOut ((bf16*)(ws + WS_WTOUT))
#define WtCin ((bf16*)(ws + WS_WTCIN))
#define WtCout ((bf16*)(ws + WS_WTCOUT))
#define WtIn ((bf16*)(ws + WS_WTIN))
#define XN ((bf16*)(ws + WS_XN))
#define YMIX ((bf16*)(ws + WS_YMIX))
#define YMIX2 ((bf16*)(ws + WS_YMIX2))
#define PROJ ((bf16*)(ws + WS_PROJ))
#define X1B ((bf16*)(ws + WS_X1B))
#define PROJ2 ((bf16*)(ws + WS_PROJ2))
#define HL ((bf16*)(ws + WS_HL))
#define PP ((bf16*)(ws + WS_PP))
    const int lo = args.ph_lo, hi = args.ph_hi;
#if MK_N_LAUNCHES == 1
    volatile LAS unsigned* xst = (volatile LAS unsigned*)((LAS unsigned char*)lds + LDS_BYTES - 64);
    if (threadIdx.x < 2) xst[threadIdx.x] = 0u;
    __syncthreads();
    XcdBarrier xbar = xcd_barrier_post((unsigned*)(WSLOAD() + WS_BAR), xst);
    if (lo > hi) cg::this_grid().sync();
#endif
#ifndef REP_PHASE
#define REP_PHASE -1
#endif
#define REPN(k) ((k) == REP_PHASE ? 2 : 1)
#ifndef PH_MASK
#define PH_MASK 0x1ff
#endif
#define IN(k) (((PH_MASK >> (k)) & 1) && lo <= (k) && (k) < hi)
#if MK_N_LAUNCHES == 1
#define SEAM(k) do { if (IN(k) && IN((k) + 1)) { xcd_barrier(xbar); } } while (0)
#else
#define SEAM(k) do { } while (0)
#endif
#ifdef TPROBE_A
    volatile unsigned long long* tsl = (volatile unsigned long long*)(lds + LDS_BYTES - 128);
#define STAMP(k) do { if (bx == 0 && threadIdx.x == 0) tsl[(k)] = __builtin_amdgcn_s_memrealtime(); } while (0)
#else
#define STAMP(k) do { } while (0)
#endif
    STAMP(0);

    if (IN(0)) { unsigned char* const ws = WSLOAD(); PH_IDS();
        for (int i = gt; i < 4 * M; i += NGT) ss1[i] = 0.f;
        float* scr = (float*)(lds + wave * 16384);
        p0_transpose_matrix(K_ab_w_in, DM, NIN, WtIn, nullptr, scr, lane, gw, NGW);
        p0_transpose_matrix(K_ab_w_out, NMIX, DM, WtOut, nullptr, scr, lane, (gw + 517) % NGW, NGW);
        p0_transpose_matrix(K_c_w_in, DM, NCIN, WtCin, K_c_norm, scr, lane, (gw + 1031) % NGW, NGW);
        if (G != 256) p0_transpose_matrix(K_c_w_out, CW, DM, WtCout, nullptr, scr, lane, (gw + 1549) % NGW, NGW);
        if (G != 256) for (int i = gt; i < 16 * 2 * 192 * 192; i += NGT) { const int ii = i % 192, j = (i / 192) % 192, gate = (i / (192 * 192)) & 1, hd = i / (2 * 192 * 192);
            float v = 0.f; if (ii < 168 && j < 168) v = (gate ? K_c_gate_x_w : K_c_gate_a_w)[((size_t)hd * 168 + ii) * 168 + j];
            WgT[i] = (bf16)f2bf(v); }
        for (int i = gt; i < 8 * 128 * 128; i += NGT) { const int j = i & 127, ii = (i >> 7) & 127; Wsb[i] = ((ii >> 6) >= (j >> 6)) ? (bf16)f2bf(K_sgu_w[i]) : (bf16)0; }
        const float* x_ = K_x; const float* abn_ = K_ab_norm;
        for (int m_ = gw; m_ < M * REPN(0); m_ += NGW) { const int m = m_ % M;
            const f32x4* xr = (const f32x4*)(x_ + (size_t)m * DM) + lane; f32x4 v[8]; float s = 0.f;
#pragma unroll
            for (int j = 0; j < 8; ++j) { v[j] = __builtin_nontemporal_load(xr + 64 * j); s += (v[j][0] * v[j][0] + v[j][1] * v[j][1]) + (v[j][2] * v[j][2] + v[j][3] * v[j][3]); }
            const float rs = rsqrtf(wave_sum(s) * (1.f / DM) + 1e-6f);
            unsigned long long* o8 = (unsigned long long*)(XN + (size_t)m * DM) + lane;
#pragma unroll
            for (int j = 0; j < 8; ++j) { const f32x4 g = ((const f32x4*)abn_)[lane + 64 * j];
                o8[64 * j] = (unsigned long long)pk2(v[j][0] * rs * g[0], v[j][1] * rs * g[1]) | ((unsigned long long)pk2(v[j][2] * rs * g[2], v[j][3] * rs * g[3]) << 32); }
        }
        __syncthreads();
    }
    SEAM(0); STAMP(1);
    if (IN(1)) { unsigned char* const ws = WSLOAD(); PH_IDS();
        pg8::Gemm g{XN, WtIn, M, NIN, DM}; pg8::StaticOrder S; S.init(M, NIN, G, bx);
        for (int rep_ = 0; rep_ < REPN(1); ++rep_) { pg8::EpiProj E{PROJ, rep_ ? nullptr : vsum, vsq, ws + WS_KVIMG};
        pg8::gemm_phase<pg8::EpiProj, pg8::StaticOrder, true, true>((LAS unsigned char*)lds, g, S, E); }
    }
    SEAM(1); STAMP(2);
    if (IN(2)) { unsigned char* const ws = WSLOAD(); PH_IDS();
        float lam;
        { const float a0 = K_ab_lambda[lane] * K_ab_lambda[128 + lane] + K_ab_lambda[64 + lane] * K_ab_lambda[192 + lane];
          const float a1 = K_ab_lambda[256 + lane] * K_ab_lambda[384 + lane] + K_ab_lambda[320 + lane] * K_ab_lambda[448 + lane];
          lam = __uint_as_float(__builtin_amdgcn_readfirstlane(__float_as_uint(__expf(wave_sum(a0)) - __expf(wave_sum(a1)) + 0.2f))); }
#ifndef NO_ATT
        { unsigned* actr = (unsigned*)(ws + WS_ACTR); volatile LAS unsigned* slotw = (volatile LAS unsigned*)((LAS unsigned char*)lds + LDS_BYTES - 32);
          const unsigned xcc = xb_xcc_id() & 7u;
          for (unsigned qi = 0; qi < 8u; ++qi) { const unsigned xq = (xcc + qi) & 7u;
            for (;;) {
              if (threadIdx.x == 0) slotw[0] = __hip_atomic_fetch_add(actr + 16 * xq, 1u, __ATOMIC_RELAXED, __HIP_MEMORY_SCOPE_AGENT);
              __syncthreads(); const unsigned slot = slotw[0]; __syncthreads();
              if (slot >= 64u) break;
              const int bh = (int)((slot >> 5) * 8u + xq), s = (int)(slot & 31u);
#pragma unroll 1
              for (int k = 0; k < 2; ++k) att::attn_unit2(bh >> 3, bh & 7, k ? s : 63 - s, k != 0, ws + WS_KVIMG, (const att::bf16*)PROJ, (att::bf16*)YMIX, lam, K_ab_head_norm, (char*)lds);
            } } }
#endif
#ifndef NO_SGU
        for (int u = vcu; u < 512 * REPN(2); u += G) att::sgu_unit((u & 511) >> 3, u & 7, (const att::bf16*)PROJ, (att::bf16*)YMIX, (const att::bf16*)Wsb, vsum, vsq, K_sgu_ln_g, K_sgu_ln_b, K_sgu_b, (char*)lds);
#endif
    }
    SEAM(2); STAMP(3);
    if (IN(3)) { unsigned char* const ws = WSLOAD(); PH_IDS();
        pg8::Gemm g{YMIX, WtOut, M, DM, NMIX}; pg8::StaticOrder S; S.init(M, DM, G, bx);
        for (int rep_ = 0; rep_ < REPN(3); ++rep_) { pg8::EpiRes<true> E{K_x, K_out, X1B, rep_ ? nullptr : ss1};
        pg8::gemm_phase<pg8::EpiRes<true>, pg8::StaticOrder, true, true>((LAS unsigned char*)lds, g, S, E); }
    }
    SEAM(3); STAMP(4);
    for (int rep_ = 0; rep_ < REPN(4); ++rep_) if (IN(4)) { unsigned char* const ws = WSLOAD(); PH_IDS();
        pg8::Gemm g{X1B, WtCin, M, NCIN, DM}; pg8::StaticOrder S; S.init(M, NCIN, G, bx);
        pg8::EpiProj2 E{PROJ2, ss1};
        pg8::gemm_phase<pg8::EpiProj2, pg8::StaticOrder, true, true>((LAS unsigned char*)lds, g, S, E);
        if (G == 256 && bx >= 160) {
            __syncthreads();
            float* scr = (float*)(lds + wave * 16384); const int gw2 = (bx - 160) * NWAVES + wave, NGW2 = 96 * NWAVES, gt2 = (bx - 160) * 512 + tid, NGT2 = 96 * 512;
            p0_transpose_matrix(K_c_w_out, CW, DM, WtCout, nullptr, scr, lane, gw2, NGW2);
            const float* gaw = K_c_gate_a_w; const float* gxw = K_c_gate_x_w;
            for (int i = gt2; i < 16 * 2 * 192 * 192; i += NGT2) { const int ii = i % 192, j = (i / 192) % 192, gate = (i / (192 * 192)) & 1, hd = i / (2 * 192 * 192);
                float v = 0.f; if (ii < 168 && j < 168) v = (gate ? gxw : gaw)[((size_t)hd * 168 + ii) * 168 + j];
                WgT[i] = (bf16)f2bf(v); }
        }
    }
    SEAM(4); STAMP(5);
    for (int rep_ = 0; rep_ < REPN(5); ++rep_) if (IN(5)) { unsigned char* const ws = WSLOAD(); PH_IDS();
        for (int u0 = vcu * 8; u0 < 2048; u0 += G * 8) { const int bh = u0 >> 6, tc0 = u0 & 63;
            lru_group(bh >> 4, bh & 15, tc0, kap, ws, (char*)lds); }
    }
    STAMP(6);
    if (false) { unsigned char* const ws = WSLOAD(); PH_IDS();
        for (int u = vcu; u < 256; u += G) carry_unit(u, HL, PP, PROJ2, sumA, sumH, YMIX2, (char*)lds);
    }
    SEAM(6); STAMP(7);
    if (IN(7)) { unsigned char* const ws = WSLOAD(); PH_IDS();
        pg8::Gemm g{YMIX2, WtCout, M, DM, CW}; pg8::StaticOrder S; S.init(M, DM, G, bx);
        if (G == 256) { pg8::EpiFinal E{K_out, K_out, ss2, (unsigned*)(ws + WS_PCNT), K_final_norm};
            pg8::gemm_phase<pg8::EpiFinal, pg8::StaticOrder, true, true>((LAS unsigned char*)lds, g, S, E); }
        else { pg8::EpiRes<false> E{K_out, K_out, nullptr, ss2};
            pg8::gemm_phase<pg8::EpiRes<false>, pg8::StaticOrder, true, true>((LAS unsigned char*)lds, g, S, E); }
    }
    if (G != 256) { SEAM(7); } STAMP(8);
    for (int rep_ = 0; rep_ < REPN(8); ++rep_) if (IN(8) && G != 256) { unsigned char* const ws = WSLOAD(); PH_IDS();
        for (int m = gw; m < M; m += NGW) { f32x4* xr = (f32x4*)(K_out + (size_t)m * DM) + lane; const float rs = rsqrtf(ss2[m] * (1.f / DM) + 1e-6f);
#pragma unroll
            for (int j = 0; j < 8; ++j) { const f32x4 g = ((const f32x4*)K_final_norm)[lane + 64 * j]; f32x4 v = xr[64 * j]; v = v * rs * g; xr[64 * j] = v; } }
    }
#ifdef TPROBE_A
    if (bx == 0 && threadIdx.x == 0) { STAMP(9); asm volatile("s_waitcnt vmcnt(0) lgkmcnt(0)" ::: "memory");
        K_out[0] = (float)(tsl[TPROBE_A + 1] - tsl[TPROBE_A]) * 0.01f; K_out[1] = (float)(tsl[TPROBE_B + 1] - tsl[TPROBE_B]) * 0.01f; }
#endif
#undef IN
#undef SEAM
}

extern "C" void kernel_launch(void* const* d_in, const int* in_sizes, int n_in, void* d_out, int out_size, void* d_ws, size_t ws_size, hipStream_t stream) {
    static int grid = 0;
    if (grid == 0) {
        if (n_in != 21 || out_size != M * DM || ws_size < WS_END) { fprintf(stderr, "kernel_launch: unexpected shapes (n_in %d out %d ws %zu)\n", n_in, out_size, ws_size); grid = -1; return; }
        int dev = 0, cus = 0, per_cu = 0;
        (void)hipGetDevice(&dev); (void)hipDeviceGetAttribute(&cus, hipDeviceAttributeMultiprocessorCount, dev);
        if (hipFuncSetAttribute((const void*)mk_fwd, hipFuncAttributeMaxDynamicSharedMemorySize, LDS_BYTES) != hipSuccess) { fprintf(stderr, "kernel_launch: hipFuncSetAttribute failed\n"); grid = -1; return; }
        (void)hipOccupancyMaxActiveBlocksPerMultiprocessor(&per_cu, (const void*)mk_fwd, NWAVES * 64, LDS_BYTES);
        (void)hipGetLastError();
        if (per_cu < 1) { fprintf(stderr, "kernel_launch: occupancy query says %d blocks per CU\n", per_cu); per_cu = 1; }
        grid = cus;
    }
    if (grid < 0) return;
    Args a{};
    for (int i = 0; i < 21; ++i) a.in[i] = (const float*)d_in[i];
    a.out = (float*)d_out; a.ws = (unsigned char*)d_ws;
#if MK_N_LAUNCHES == 1
    a.ph_lo = 0; a.ph_hi = 9;
    (void)hipMemsetAsync((char*)d_ws + WS_BAR, 0, 65536, stream);
    void* kargs[] = {&a};
    hipError_t e = hipLaunchCooperativeKernel((const void*)mk_fwd, dim3(grid), dim3(NWAVES * 64), kargs, LDS_BYTES, stream);
    if (e != hipSuccess) fprintf(stderr, "kernel_launch: cooperative launch failed: %s (grid %d)\n", hipGetErrorString(e), grid);
#else
    for (int p = 0; p < 9; ++p) { a.ph_lo = p; a.ph_hi = p + 1; hipLaunchKernelGGL(mk_fwd, dim3(grid), dim3(NWAVES * 64), LDS_BYTES, stream, a); }
#endif
}
```
